# Optimizing an MI355X kernel written in HIP

```python
import functools
import jax, jax.numpy as jnp
from jax import lax
import numpy as np

D_MODEL = 2048
BATCH = 1
SEQ = 16384
DEPTH = 1
DEC_BATCH = 32
DEC_SEQ = 1
PAST_LEN = 16384
PAGE_SIZE = 128

ATT_HEADS = 8
HEAD_DIM = 128
ATT_WIDTH = ATT_HEADS * HEAD_DIM
DILATED_PATTERNS = ((128, 1), (512, 4), (2048, 16))
WINDOW = max(w for w, _ in DILATED_PATTERNS)
Q_BLOCK = 128
HG_HEADS = 8
HG_DK = 128
HG_DV = (D_MODEL - ATT_WIDTH) // HG_HEADS
HG_KWIDTH = HG_HEADS * HG_DK
HG_VWIDTH = HG_HEADS * HG_DV
HG_CHUNK = 64
MIX_WIDTH = ATT_WIDTH + HG_VWIDTH
IN_WIDTH = 3 * ATT_WIDTH + 2 * HG_KWIDTH + 2 * HG_VWIDTH
IN_SPLITS = (ATT_WIDTH, 2 * ATT_WIDTH, 3 * ATT_WIDTH,
             3 * ATT_WIDTH + HG_KWIDTH, 3 * ATT_WIDTH + 2 * HG_KWIDTH,
             3 * ATT_WIDTH + 2 * HG_KWIDTH + HG_VWIDTH)
D_FF = -(-(8 * D_MODEL) // (3 * 256)) * 256
EPS = 1e-6

kernel_name = 'hymba_dilated_attn_hgrn2_decode_step'


def rmsnorm(x, g):
    xf = x.astype(jnp.float32)
    y = xf * lax.rsqrt(jnp.mean(xf * xf, axis=-1, keepdims=True) + EPS)
    return (y * g.astype(jnp.float32)).astype(x.dtype)


def dilated_attention(q, k_all, v_all, q_idx):
    scale = HEAD_DIM ** -0.5
    lses, outs = [], []
    for window, dil in DILATED_PATTERNS:
        n_keys = window // dil + 1
        idx = q_idx[:, None] - dil * jnp.arange(n_keys, dtype=jnp.int32)[None, :]
        valid = idx >= 0
        idx_c = jnp.maximum(idx, 0)
        kg = jnp.take(k_all, idx_c, axis=1)
        vg = jnp.take(v_all, idx_c, axis=1)
        s = jnp.einsum('bqhd,bqjhd->bhqj', q, kg).astype(jnp.float32) * scale
        s = jnp.where(valid[None, None], s, -jnp.inf)
        lse = jax.nn.logsumexp(s, axis=-1)
        p = jnp.exp(s - lse[..., None])
        o = jnp.einsum('bhqj,bqjhd->bqhd', p.astype(v_all.dtype), vg)
        lses.append(lse)
        outs.append(o.astype(jnp.float32))
    w = jax.nn.softmax(jnp.stack(lses, 0), axis=0)
    w = jnp.transpose(w, (0, 1, 3, 2))[..., None]
    return jnp.sum(w * jnp.stack(outs, 0), axis=0).astype(q.dtype)


def prompt_attend(q, k, v):
    b, t, h, dh = q.shape
    nb = t // Q_BLOCK
    qb = jnp.transpose(q.reshape(b, nb, Q_BLOCK, h, dh), (1, 0, 2, 3, 4))
    pos = jnp.arange(t, dtype=jnp.int32).reshape(nb, Q_BLOCK)
    o = lax.map(lambda a: dilated_attention(a[0], k, v, a[1]), (qb, pos))
    o = jnp.transpose(o, (1, 0, 2, 3, 4)).reshape(b, t, h, dh)
    keep = min(WINDOW, t)
    return o, (k[:, t - keep:], v[:, t - keep:])


def sample_attend(q, k, v, cache_k, cache_v):
    past = cache_k.shape[1]
    k_all = jnp.concatenate([cache_k.astype(k.dtype), k], axis=1)
    v_all = jnp.concatenate([cache_v.astype(v.dtype), v], axis=1)
    q_idx = past + jnp.arange(q.shape[1], dtype=jnp.int32)
    return dilated_attention(q, k_all, v_all, q_idx), (k, v)


def hgrn_chunked(q, k, v, logf, s0, chunk):
    b_, t = q.shape[:2]
    n = t // chunk

    def to_chunks(a):
        return jnp.moveaxis(a.astype(jnp.float32).reshape(b_, n, chunk, *a.shape[2:]), 1, 0)

    causal = jnp.tril(jnp.ones((chunk, chunk), dtype=bool))[None, :, :, None, None]

    def step(s, xs):
        qc, kc, vc, gc = xs
        cum = jnp.cumsum(gc, axis=1)
        o_inter = jnp.einsum('bthk,bhkv->bthv', qc * jnp.exp(cum), s)
        decay = jnp.exp(jnp.where(causal, cum[:, :, None] - cum[:, None, :], -jnp.inf))
        a = jnp.einsum('bthk,bshk,btshk->bhts', qc, kc, decay)
        o_intra = jnp.einsum('bhts,bshv->bthv', a, vc)
        last = cum[:, -1]
        k_dec = kc * jnp.exp(last[:, None] - cum)
        s_new = jnp.exp(last)[..., None] * s + jnp.einsum('bshk,bshv->bhkv', k_dec, vc)
        return s_new, o_inter + o_intra

    s_fin, o = lax.scan(step, s0.astype(jnp.float32), (to_chunks(q), to_chunks(k), to_chunks(v), to_chunks(logf)))
    o = jnp.moveaxis(o, 0, 1).reshape(b_, t, *v.shape[2:])
    return o, s_fin


def decoder_layer(x, lb, n_pre_mix, w_in, attn_gain, hg_gain, w_out, n_post_mix,
                  n_pre_ffn, w_gate, w_up, w_down, n_post_ffn, attend, recur):
    b, t, _ = x.shape
    h = rmsnorm(x, n_pre_mix)
    proj = jnp.einsum('btd,de->bte', h, w_in)
    q_a, k_a, v_a, q_h, f_h, i_h, g_h = jnp.split(proj, IN_SPLITS, axis=-1)
    heads = lambda a, nh: a.reshape(b, t, nh, -1)
    o_att, kv_new = attend(heads(q_a, ATT_HEADS), heads(k_a, ATT_HEADS), heads(v_a, ATT_HEADS))
    f = lb + (1.0 - lb) * jax.nn.sigmoid(heads(f_h, HG_HEADS).astype(jnp.float32))
    qh = jax.nn.silu(heads(q_h, HG_HEADS).astype(jnp.float32))
    o_hg, s_new = recur(qh, 1.0 - f, heads(i_h, HG_HEADS).astype(jnp.float32), jnp.log(f))
    o_att = rmsnorm(o_att.reshape(b, t, ATT_WIDTH), attn_gain)
    o_hg = rmsnorm(o_hg, hg_gain) * jax.nn.silu(heads(g_h, HG_HEADS).astype(jnp.float32))
    merged = jnp.concatenate([o_att.astype(x.dtype), o_hg.reshape(b, t, HG_VWIDTH).astype(x.dtype)], axis=-1)
    mix = jnp.einsum('bte,ed->btd', merged, w_out)
    x = x + rmsnorm(mix, n_post_mix)
    h = rmsnorm(x, n_pre_ffn)
    ff = jax.nn.silu(jnp.einsum('btd,df->btf', h, w_gate)) * jnp.einsum('btd,df->btf', h, w_up)
    ff = jnp.einsum('btf,fd->btd', ff, w_down)
    x = x + rmsnorm(ff, n_post_ffn)
    return x, kv_new, s_new


def setup_inputs(seed: int = 0) -> dict:
    key = jax.random.key(seed)
    ks = jax.random.split(key, 20)
    f32 = jnp.float32
    nrm = lambda k, shape, s: jax.random.normal(k, shape, f32) * s
    gain = lambda k, shape: 1.0 + 0.1 * jax.random.normal(k, shape, f32)
    past_rows = min(WINDOW, PAST_LEN)
    return {
        'x_prompt': nrm(ks[0], (BATCH, SEQ, D_MODEL), 1.0),
        'x_sample': nrm(ks[1], (DEC_BATCH, DEC_SEQ, D_MODEL), 1.0),
        'cache_win_k': nrm(ks[2], (DEPTH, DEC_BATCH, past_rows, ATT_HEADS, HEAD_DIM), 1.0),
        'cache_win_v': nrm(ks[3], (DEPTH, DEC_BATCH, past_rows, ATT_HEADS, HEAD_DIM), 1.0),
        'state_hgrn': nrm(ks[4], (DEPTH, DEC_BATCH, HG_HEADS, HG_DK, HG_DV), 0.3),
        'norm_pre_mix': gain(ks[5], (DEPTH, D_MODEL)),
        'w_in': nrm(ks[6], (DEPTH, D_MODEL, IN_WIDTH), D_MODEL ** -0.5),
        'hg_lb_logits': nrm(ks[7], (DEPTH + 1, HG_KWIDTH), 0.5),
        'attn_out_gain': gain(ks[8], (DEPTH, ATT_WIDTH)),
        'hg_norm_gain': gain(ks[9], (DEPTH, HG_DV)),
        'w_out': nrm(ks[10], (DEPTH, MIX_WIDTH, D_MODEL), MIX_WIDTH ** -0.5),
        'norm_post_mix': gain(ks[11], (DEPTH, D_MODEL)),
        'norm_pre_ffn': gain(ks[12], (DEPTH, D_MODEL)),
        'w_gate': nrm(ks[13], (DEPTH, D_MODEL, D_FF), D_MODEL ** -0.5),
        'w_up': nrm(ks[14], (DEPTH, D_MODEL, D_FF), D_MODEL ** -0.5),
        'w_down': nrm(ks[15], (DEPTH, D_FF, D_MODEL), D_FF ** -0.5),
        'norm_post_ffn': gain(ks[16], (DEPTH, D_MODEL)),
    }


def reference(x_prompt, x_sample, cache_win_k, cache_win_v, state_hgrn, norm_pre_mix, w_in,
              hg_lb_logits, attn_out_gain, hg_norm_gain, w_out, norm_post_mix, norm_pre_ffn,
              w_gate, w_up, w_down, norm_post_ffn):
    lb_all = jnp.cumsum(jax.nn.softmax(hg_lb_logits.astype(jnp.float32), axis=0), axis=0)
    yp, ys = x_prompt, x_sample
    kp, vp, sp, ksm, vsm, ssm = [], [], [], [], [], []
    for l in range(DEPTH):
        lb = lb_all[l].reshape(HG_HEADS, HG_DK)
        params = (norm_pre_mix[l], w_in[l], attn_out_gain[l], hg_norm_gain[l], w_out[l],
                  norm_post_mix[l], norm_pre_ffn[l], w_gate[l], w_up[l], w_down[l], norm_post_ffn[l])
        s0 = jnp.zeros((x_prompt.shape[0], HG_HEADS, HG_DK, HG_DV), jnp.float32)
        yp, (k1, v1), s1 = decoder_layer(
            yp, lb, *params, attend=prompt_attend,
            recur=functools.partial(hgrn_chunked, s0=s0, chunk=HG_CHUNK))
        ys, (k2, v2), s2 = decoder_layer(
            ys, lb, *params,
            attend=functools.partial(sample_attend, cache_k=cache_win_k[l], cache_v=cache_win_v[l]),
            recur=functools.partial(hgrn_chunked, s0=state_hgrn[l], chunk=x_sample.shape[1]))
        kp.append(k1); vp.append(v1); sp.append(s1)
        ksm.append(k2); vsm.append(v2); ssm.append(s2)
    return (yp, ys, jnp.stack(kp), jnp.stack(vp), jnp.stack(sp), jnp.stack(ksm), jnp.stack(vsm), jnp.stack(ssm))
```

```cpp
#include <hip/hip_runtime.h>
#include <hip/hip_cooperative_groups.h>
#include <cstdio>
namespace cg = cooperative_groups;

#ifndef MK_SETTLE
#define MK_SETTLE 0
#endif
#ifndef MK_VAR
#define MK_VAR 0
#endif
#ifndef MK_SUB
#define MK_SUB 0
#endif
#ifndef MK_DBG
#define MK_DBG 0
#endif
#ifndef MK_NPH
#define MK_NPH 10
#endif
#ifndef MK_FUSED
#define MK_FUSED 1
#endif

typedef unsigned short bf16_t;
typedef short s16x8 __attribute__((ext_vector_type(8)));
typedef short s16x4 __attribute__((ext_vector_type(4)));
typedef float f32x4 __attribute__((ext_vector_type(4)));
typedef unsigned u32x4 __attribute__((ext_vector_type(4)));
typedef unsigned u32x2 __attribute__((ext_vector_type(2)));

constexpr int T_ = 16384, D_ = 2048, NIN = 7168, DFF = 5632, NBS = 32, PAST = 2048;
constexpr int NCH = 256;
constexpr float EPS_ = 1e-6f;
constexpr int LDS_BYTES = 131072;

constexpr size_t WS_WIN = 0;
constexpr size_t WS_WOUT = WS_WIN + (size_t)NIN * D_ * 2;
constexpr size_t WS_WGU = WS_WOUT + (size_t)D_ * D_ * 2;
constexpr size_t WS_WD = WS_WGU + (size_t)2 * DFF * D_ * 2;
constexpr size_t WS_H = WS_WD + (size_t)D_ * DFF * 2;
constexpr size_t WS_QC = WS_H + (size_t)T_ * D_ * 2;
constexpr size_t WS_KC = WS_QC + (size_t)T_ * 1024 * 2;
constexpr size_t WS_VT = WS_KC + (size_t)T_ * 1024 * 2;
constexpr size_t WS_HG = WS_VT + (size_t)T_ * 1024 * 2;
constexpr size_t WS_FF = WS_QC;
constexpr size_t WS_OATT = WS_HG + (size_t)T_ * 4096 * 2;
constexpr size_t WS_U = WS_OATT + (size_t)T_ * 1024 * 2;
constexpr size_t WS_DD = WS_U + (size_t)NCH * 8 * 128 * 128 * 4;
constexpr size_t WS_MRG = WS_DD + (size_t)NCH * 1024 * 4;
constexpr size_t WS_MIX = WS_MRG + (size_t)T_ * D_ * 2;
constexpr size_t WS_SSQ = WS_MIX + (size_t)T_ * D_ * 4;
constexpr size_t WS_S0 = WS_SSQ + (size_t)T_ * 4;
constexpr size_t WS_HS = WS_S0;
constexpr size_t WS_PROJS = WS_HS + 32 * 2048 * 2;
constexpr size_t WS_OATTS = WS_PROJS + 32 * 7168 * 4;
constexpr size_t WS_OHGS = WS_OATTS + 32 * 1024 * 4;
constexpr size_t WS_MRGS = WS_OHGS + 32 * 1024 * 4;
constexpr size_t WS_MIXS = WS_MRGS + 32 * 2048 * 2;
constexpr size_t WS_H2S = WS_MIXS + 32 * 2048 * 4;
constexpr size_t WS_FFS = WS_H2S + 32 * 2048 * 2;
constexpr size_t WS_FFOS = WS_FFS + 32 * 5632 * 2;
constexpr size_t WS_END = WS_FFOS + 32 * 2048 * 4;

constexpr size_t O_YP = 0;
constexpr size_t O_YS = O_YP + (size_t)T_ * D_;
constexpr size_t O_WKP = O_YS + 32 * 2048;
constexpr size_t O_WVP = O_WKP + (size_t)2048 * 1024;
constexpr size_t O_STP = O_WVP + (size_t)2048 * 1024;
constexpr size_t O_WKS = O_STP + 8 * 128 * 128;
constexpr size_t O_WVS = O_WKS + 32 * 1024;
constexpr size_t O_STS = O_WVS + 32 * 1024;

struct Params {
    const float* x_prompt; const float* x_sample; const float* cache_k; const float* cache_v; const float* state_in;
    const float* n_pre_mix; const float* w_in; const float* lb_logits; const float* attn_gain; const float* hg_gain;
    const float* w_out; const float* n_post_mix; const float* n_pre_ffn; const float* w_gate; const float* w_up;
    const float* w_down; const float* n_post_ffn;
    float* out; unsigned char* ws;
    int ph_lo, ph_hi;
};

typedef __bf16 bf16x2v_ __attribute__((ext_vector_type(2)));
typedef float f32x2v_ __attribute__((ext_vector_type(2)));
__device__ __forceinline__ unsigned pk2(float lo, float hi) { const f32x2v_ f = {lo, hi}; const bf16x2v_ b = __builtin_convertvector(f, bf16x2v_); return __builtin_bit_cast(unsigned, b); }
__device__ __forceinline__ bf16_t f2bf(float f) { unsigned u = __float_as_uint(f); u += 0x7FFFu + ((u >> 16) & 1u); return (bf16_t)(u >> 16); }
__device__ __forceinline__ float bf2f(bf16_t b) { return __uint_as_float(((unsigned)b) << 16); }
__device__ __forceinline__ float bflo(unsigned w) { return __uint_as_float(w << 16); }
__device__ __forceinline__ float bfhi(unsigned w) { return __uint_as_float(w & 0xffff0000u); }
__device__ __forceinline__ float wave_sum(float v) {
#pragma unroll
    for (int o = 1; o < 64; o <<= 1) v += __shfl_xor(v, o);
    return v;
}
__device__ __forceinline__ float sigmoidf_(float x) { return 1.f / (1.f + __expf(-x)); }
__device__ __forceinline__ float siluf_(float x) { return x / (1.f + __expf(-x)); }

namespace pg8 {
#define PG8_LAS __attribute__((address_space(3)))
typedef unsigned short bf16_t;
typedef short bf16x8 __attribute__((ext_vector_type(8)));
typedef float f32x4 __attribute__((ext_vector_type(4)));
typedef unsigned u32x4 __attribute__((ext_vector_type(4)));
constexpr int BM = 256, BK = 64, HALF = 128, HTB = HALF * BK * 2  , STAGE_BYTES = 8 * HTB, NXCD = 8, WGM = 8;

__host__ __device__ __forceinline__ int lds_byte(int r, int c) { const int st = (r >> 4) * 2 + (c >> 5), rr = r & 15, cc = c & 31, ob = rr * 64 + cc * 2; return st * 1024 + (ob ^ (((ob >> 9) & 1) << 5)); }
__host__ __device__ __forceinline__ void stage_rc(int b, int& R, int& C) { const int st = b / 1024, sb = b % 1024, swz = sb ^ (((sb >> 9) & 1) << 5); R = (st >> 1) * 16 + swz / 64; C = (st & 1) * 32 + (swz % 64) / 2; }
__host__ __device__ __forceinline__ int perm32(int rho) { const int n = rho >> 4, i = rho & 15; return 8 * (i >> 2) + 4 * n + (i & 3); }

struct Unit { int pm, pn; };
struct Gemm { const bf16_t* A; const bf16_t* Bt; int M, N, K; };

struct StaticOrder {
    int nM, nN, nwg, G, c;
    __host__ __device__ void init(int M, int N, int G_, int c_) { nM = M / BM; nN = N / BM; nwg = nM * nN; G = G_; c = c_; }
    __host__ __device__ bool next(int i, Unit& u) const {
        const long L = (long)i * G + c; if (L >= nwg) return false;
        int wgid = (int)L; { const int q = nwg / NXCD, r = nwg % NXCD, xcd = wgid % NXCD, off = wgid / NXCD; wgid = (xcd < r ? xcd * (q + 1) : r * (q + 1) + (xcd - r) * q) + off; }
        const int nig = WGM * nN, gid = wgid / nig, fm = gid * WGM, gsz = (nM - fm) < WGM ? (nM - fm) : WGM;
        u.pm = fm + ((wgid % nig) % gsz); u.pn = (wgid % nig) / gsz; return true;
    }
    __device__ __forceinline__ void a_ready(const Unit&) const {}
    __device__ __forceinline__ void done(const Unit&) const {}
};
__device__ __forceinline__ unsigned cvt_pk_bf16(float lo, float hi) { unsigned r; asm volatile("v_cvt_pk_bf16_f32 %0, %1, %2" : "=v"(r) : "v"(lo), "v"(hi)); return r; }
template <class Epi, class Sched, bool STAMP = false>
__device__ __forceinline__ void gemm_phase(PG8_LAS unsigned char* lds, const Gemm g, const Sched& S, const Epi& E, unsigned long long* stamps) {
    const int tid = threadIdx.x, wid = __builtin_amdgcn_readfirstlane(tid >> 6), lane = tid & 63, wr = wid >> 2, wc = wid & 3, fr = lane & 15, fq = lane >> 4;
    const int K = g.K, nt = K / BK;
    int ts_lo = 0, ts_hi = 0, nts = 0; const unsigned long long rt_entry = STAMP ? (unsigned long long)wall_clock64() : 0ull;
#define PG8_STAMP() do { if (STAMP && wid == 0 && nts < 64) { const unsigned long long _c = (unsigned long long)clock64(); \
        ts_lo = (lane == nts) ? (int)(unsigned)_c : ts_lo; ts_hi = (lane == nts) ? (int)(unsigned)(_c >> 32) : ts_hi; ++nts; } } while (0)
    PG8_STAMP();
    unsigned voffA[2], voffB[2];
#pragma unroll
    for (int i = 0; i < 2; ++i) { int R, C; stage_rc(tid * 16 + i * 8192, R, C); const int Rb = Epi::PERM ? ((R & ~31) + perm32(R & 31)) : R;
        voffA[i] = (unsigned)(R * K + C) * 2u; voffB[i] = (unsigned)(Rb * K + C) * 2u; }
    const size_t kstep = (size_t)(BK * 2);
    const size_t hstep = (size_t)HALF * K * 2;
    const size_t tstep = 2 * hstep;
    const unsigned ldsw = (unsigned)wid * 1024u;
    const int aoff = lds_byte(wr * 64 + fr, fq * 8), boff = lds_byte(wc * 32 + fr, fq * 8);
#define PG8_SA(b, h) (((b) * 2 + (h)) * HTB)
#define PG8_SB(b, h) ((4 + (b) * 2 + (h)) * HTB)
#define PG8_STAGE(bufoff, gbase, voff) do { _Pragma("unroll") for (int _i = 0; _i < 2; ++_i) \
        __builtin_amdgcn_global_load_lds((const unsigned*)((const char*)(gbase) + (voff)[_i]), (PG8_LAS unsigned*)(lds + (bufoff) + ldsw + _i * 8192), 16, 0, 0); } while (0)
#define PG8_LDA(dst, b, h) do { _Pragma("unroll") for (int m = 0; m < 4; ++m) _Pragma("unroll") for (int k = 0; k < 2; ++k) dst[m][k] = *(const PG8_LAS bf16x8*)(lds + PG8_SA(b, h) + aoff + m * 2048 + k * 1024); } while (0)
#define PG8_LDB(dst, b, h) do { _Pragma("unroll") for (int n = 0; n < 2; ++n) _Pragma("unroll") for (int k = 0; k < 2; ++k) dst[n][k] = *(const PG8_LAS bf16x8*)(lds + PG8_SB(b, h) + boff + n * 2048 + k * 1024); } while (0)
#define PG8_MMA(ai, bj, At, Bt) do { __builtin_amdgcn_s_setprio(1); _Pragma("unroll") for (int m = 0; m < 4; ++m) _Pragma("unroll") for (int n = 0; n < 2; ++n) _Pragma("unroll") for (int k = 0; k < 2; ++k) \
        acc[ai][bj][m][n] = __builtin_amdgcn_mfma_f32_16x16x32_bf16(Bt[n][k], At[m][k], acc[ai][bj][m][n], 0, 0, 0); __builtin_amdgcn_s_setprio(0); } while (0)
#define PG8_WAIT_V(n) asm volatile("s_waitcnt vmcnt(" #n ")" ::: "memory")
#define PG8_WAIT_L(n) asm volatile("s_waitcnt lgkmcnt(" #n ")" ::: "memory")
#define PG8_BAR __builtin_amdgcn_s_barrier()
#define PG8_SCHED __builtin_amdgcn_sched_barrier(0)
    Unit cur, nxt; int ui = 0;
    if (!S.next(0, cur)) return;
    f32x4 acc[2][2][4][2];
#pragma unroll
    for (int a = 0; a < 2; ++a)
#pragma unroll
        for (int b = 0; b < 2; ++b)
#pragma unroll
            for (int m = 0; m < 4; ++m)
#pragma unroll
                for (int n = 0; n < 2; ++n) acc[a][b][m][n] = (f32x4){0.f, 0.f, 0.f, 0.f};
    bf16x8 At[4][2], B0[2][2], B1[2][2];
    const char* cA = (const char*)g.A + (size_t)cur.pm * tstep; const char* cB = (const char*)g.Bt + (size_t)cur.pn * tstep;
    S.a_ready(cur);
    PG8_STAGE(PG8_SB(0, 0), cB, voffB); PG8_STAGE(PG8_SA(0, 0), cA, voffA); PG8_STAGE(PG8_SB(0, 1), cB + hstep, voffB); PG8_STAGE(PG8_SA(0, 1), cA + hstep, voffA);
    if (wr == 1) PG8_BAR;
    PG8_WAIT_V(4); PG8_BAR;
    PG8_STAGE(PG8_SB(1, 0), cB + kstep, voffB); PG8_STAGE(PG8_SA(1, 0), cA + kstep, voffA); PG8_STAGE(PG8_SB(1, 1), cB + hstep + kstep, voffB);
    PG8_WAIT_V(6); PG8_BAR;
    PG8_STAMP();
    for (;;) {
        const bool has_next = S.next(ui + 1, nxt);
        const char* nA = has_next ? (const char*)g.A + (size_t)nxt.pm * tstep : cA; const char* nB = has_next ? (const char*)g.Bt + (size_t)nxt.pn * tstep : cB;
        for (int t = 0; t < nt; t += 2) {
            const bool last = (t == nt - 2);
            const char* a1 = cA + (size_t)(t + 1) * kstep;
            const char* a2 = last ? nA : cA + (size_t)(t + 2) * kstep; const char* b2 = last ? nB : cB + (size_t)(t + 2) * kstep;
            const char* a3 = a2 + kstep; const char* b3 = b2 + kstep;
            if (last && has_next) S.a_ready(nxt);
            PG8_LDB(B0, 0, 0); PG8_SCHED; PG8_LDA(At, 0, 0); PG8_STAGE(PG8_SA(1, 1), a1 + hstep, voffA);
            PG8_WAIT_L(8); PG8_BAR; PG8_WAIT_L(0); PG8_MMA(0, 0, At, B0); PG8_BAR; PG8_SCHED;
            PG8_LDB(B1, 0, 1); PG8_STAGE(PG8_SB(0, 0), b2, voffB);
            PG8_BAR; PG8_WAIT_L(0); PG8_MMA(0, 1, At, B1); PG8_BAR;
            PG8_LDA(At, 0, 1); PG8_STAGE(PG8_SA(0, 0), a2, voffA);
            PG8_BAR; PG8_WAIT_L(0); PG8_MMA(1, 0, At, B0); PG8_BAR; PG8_SCHED;
            PG8_STAGE(PG8_SB(0, 1), b2 + hstep, voffB);
            PG8_WAIT_V(6); PG8_BAR; PG8_MMA(1, 1, At, B1); PG8_BAR;
            PG8_LDB(B0, 1, 0); PG8_SCHED; PG8_LDA(At, 1, 0); PG8_STAGE(PG8_SA(0, 1), a2 + hstep, voffA);
            PG8_WAIT_L(8); PG8_BAR; PG8_WAIT_L(0); PG8_MMA(0, 0, At, B0); PG8_BAR; PG8_SCHED;
            PG8_LDB(B1, 1, 1); PG8_STAGE(PG8_SB(1, 0), b3, voffB);
            PG8_BAR; PG8_WAIT_L(0); PG8_MMA(0, 1, At, B1); PG8_BAR;
            PG8_LDA(At, 1, 1); PG8_STAGE(PG8_SA(1, 0), a3, voffA);
            PG8_BAR; PG8_WAIT_L(0); PG8_MMA(1, 0, At, B0); PG8_BAR; PG8_SCHED;
            PG8_STAGE(PG8_SB(1, 1), b3 + hstep, voffB);
            PG8_WAIT_V(6); PG8_BAR; PG8_MMA(1, 1, At, B1); PG8_BAR;
        }
        PG8_STAMP();
        if constexpr (!Epi::AFTER_DRAIN) { E(acc, cur, wr, wc, fr, fq); S.done(cur); }
        PG8_STAMP();
        if (!has_next) break;
#pragma unroll
        for (int a = 0; a < 2; ++a)
#pragma unroll
            for (int b = 0; b < 2; ++b)
#pragma unroll
                for (int m = 0; m < 4; ++m)
#pragma unroll
                    for (int n = 0; n < 2; ++n) acc[a][b][m][n] = (f32x4){0.f, 0.f, 0.f, 0.f};
        cur = nxt; cA = nA; cB = nB; ++ui;
    }
    PG8_WAIT_V(0);
    if (wr == 0) PG8_BAR;
    PG8_BAR;
    if constexpr (Epi::AFTER_DRAIN) { E.fused(acc, cur, wr, wc, fr, fq, lds, wid, lane); S.done(cur); }
    PG8_STAMP();
    if (STAMP && wid == 0) { stamps[lane] = lane < nts ? (((unsigned long long)(unsigned)ts_hi << 32) | (unsigned)ts_lo) : 0ull;
        if (lane == 62) stamps[62] = rt_entry; if (lane == 63) stamps[63] = (unsigned long long)wall_clock64(); }
#undef PG8_STAMP
#undef PG8_SA
#undef PG8_SB
#undef PG8_STAGE
#undef PG8_LDA
#undef PG8_LDB
#undef PG8_MMA
#undef PG8_WAIT_V
#undef PG8_WAIT_L
#undef PG8_BAR
#undef PG8_SCHED
}
}

using pg8::Unit;
struct EpiF32 {
    static constexpr bool PERM = false, AFTER_DRAIN = false;
    float* C; int ldc;
    __device__ __forceinline__ void operator()(const f32x4 (&acc)[2][2][4][2], const Unit& u, int wr, int wc, int fr, int fq) const {
        const int row0 = u.pm * 256 + wr * 64 + fr, col0 = u.pn * 256 + wc * 32 + 4 * fq;
#pragma unroll
        for (int ai = 0; ai < 2; ++ai)
#pragma unroll
            for (int m = 0; m < 4; ++m) { float* rowp = C + (size_t)(row0 + ai * 128 + m * 16) * ldc + col0;
#pragma unroll
                for (int bj = 0; bj < 2; ++bj)
#pragma unroll
                    for (int n = 0; n < 2; ++n) *(f32x4*)(rowp + bj * 128 + n * 16) = acc[ai][bj][m][n]; }
    }
};
struct EpiSwiGLU {
    static constexpr bool PERM = true, AFTER_DRAIN = false;
    bf16_t* FF;
    __device__ __forceinline__ void operator()(const f32x4 (&acc)[2][2][4][2], const Unit& u, int wr, int wc, int fr, int fq) const {
        const int row0 = u.pm * 256 + wr * 64 + fr, col0 = u.pn * 128 + wc * 32 + 8 * fq;
#pragma unroll
        for (int ai = 0; ai < 2; ++ai)
#pragma unroll
            for (int m = 0; m < 4; ++m) {
                const f32x4 g0 = acc[ai][0][m][0], g1 = acc[ai][0][m][1], u0 = acc[ai][1][m][0], u1 = acc[ai][1][m][1];
                u32x4 w;
                w.x = pk2(siluf_(g0[0]) * u0[0], siluf_(g0[1]) * u0[1]); w.y = pk2(siluf_(g0[2]) * u0[2], siluf_(g0[3]) * u0[3]);
                w.z = pk2(siluf_(g1[0]) * u1[0], siluf_(g1[1]) * u1[1]); w.w = pk2(siluf_(g1[2]) * u1[2], siluf_(g1[3]) * u1[3]);
                *(u32x4*)(FF + (size_t)(row0 + ai * 128 + m * 16) * DFF + col0) = w; }
    }
};
struct EpiIn {
    static constexpr bool PERM = true, AFTER_DRAIN = false;
    bf16_t* QC; bf16_t* KC; bf16_t* VT; bf16_t* HG; float* outk; float* outv; float qscale;
    __device__ __forceinline__ void operator()(const f32x4 (&acc)[2][2][4][2], const Unit& u, int wr, int wc, int fr, int fq) const {
        const int region = u.pn >> 2;
#pragma unroll
        for (int ai = 0; ai < 2; ++ai)
#pragma unroll
            for (int m = 0; m < 4; ++m) {
                const int t = u.pm * 256 + ai * 128 + wr * 64 + m * 16 + fr;
#pragma unroll
                for (int bj = 0; bj < 2; ++bj) {
                    f32x4 v0 = acc[ai][bj][m][0], v1 = acc[ai][bj][m][1];
                    if (region >= 3) {
                        u32x4 w; w.x = pk2(v0[0], v0[1]); w.y = pk2(v0[2], v0[3]); w.z = pk2(v1[0], v1[1]); w.w = pk2(v1[2], v1[3]);
                        *(u32x4*)(HG + (size_t)t * 4096 + (u.pn - 12) * 256 + bj * 128 + wc * 32 + 8 * fq) = w;
                    } else {
                        const int h = (u.pn & 3) * 2 + bj, d = wc * 32 + 8 * fq, rho = t & 15, uu = t >> 4;
                        if (region == 0) {
                            v0 = v0 * qscale; v1 = v1 * qscale;
                            u32x4 w; w.x = pk2(v0[0], v0[1]); w.y = pk2(v0[2], v0[3]); w.z = pk2(v1[0], v1[1]); w.w = pk2(v1[2], v1[3]);
                            *(u32x4*)(QC + ((size_t)(h * 16 + rho) * 1024 + uu) * 128 + d) = w;
                        } else if (region == 1) {
                            u32x4 w; w.x = pk2(v0[0], v0[1]); w.y = pk2(v0[2], v0[3]); w.z = pk2(v1[0], v1[1]); w.w = pk2(v1[2], v1[3]);
                            *(u32x4*)(KC + ((size_t)(h * 16 + rho) * 1024 + uu) * 128 + d) = w;
                            if (t >= T_ - 2048) { float* o = outk + (size_t)(t - (T_ - 2048)) * 1024 + h * 128 + d; *(f32x4*)o = v0; *(f32x4*)(o + 4) = v1; }
                        } else {
                            bf16_t* vb = VT + ((size_t)(h * 16 + rho) * 128 + d) * 1024 + uu;
#pragma unroll
                            for (int j = 0; j < 4; ++j) { vb[(size_t)j * 1024] = f2bf(v0[j]); vb[(size_t)(4 + j) * 1024] = f2bf(v1[j]); }
                            if (t >= T_ - 2048) { float* o = outv + (size_t)(t - (T_ - 2048)) * 1024 + h * 128 + d; *(f32x4*)o = v0; *(f32x4*)(o + 4) = v1; }
                        }
                    }
                }
            }
    }
};

#define WS_PTR(type, off) ((type*)(P.ws + (off)))
#define LDS_WAIT() asm volatile("s_waitcnt lgkmcnt(0)" ::: "memory")
#if MK_SETTLE
#define SETTLE() do { __builtin_amdgcn_sched_barrier(0); asm volatile("s_nop 15\n\ts_nop 15"); __builtin_amdgcn_sched_barrier(0); } while (0)
#else
#define SETTLE() do {} while (0)
#endif

__device__ __forceinline__ void transpose_item(const float* W, int K, int N, bf16_t* WT, int grp, int gstride, int goff, float* scr, int item, int lane) {
    const int nblk = N / 32, kb = item / nblk, nb = item % nblk, k0 = 64 * kb, n0 = 32 * nb;
    const int rowbase = (n0 / grp) * gstride + (n0 % grp) + goff;
#pragma unroll 8
    for (int i = 0; i < 32; ++i) { const int kk = 2 * i + (lane >> 5); scr[kk * 33 + (lane & 31)] = W[(size_t)(k0 + kk) * N + n0 + (lane & 31)]; }
    LDS_WAIT();
    const int c = lane & 7;
#pragma unroll
    for (int j = 0; j < 4; ++j) { const int n = (lane >> 3) + 8 * j; const float* s = scr + (8 * c) * 33 + n;
        u32x4 o; o.x = pk2(s[0 * 33], s[1 * 33]); o.y = pk2(s[2 * 33], s[3 * 33]); o.z = pk2(s[4 * 33], s[5 * 33]); o.w = pk2(s[6 * 33], s[7 * 33]);
        *(u32x4*)(WT + (size_t)(rowbase + n) * K + k0 + 8 * c) = o; }
    LDS_WAIT();
}
__device__ __forceinline__ void rms_row_bf16(const float* x, const float* g, bf16_t* o, int lane) {
    f32x4 v[8]; float ss = 0.f;
#pragma unroll
    for (int j = 0; j < 8; ++j) { v[j] = ((const f32x4*)x)[lane + 64 * j]; ss += v[j][0] * v[j][0] + v[j][1] * v[j][1] + v[j][2] * v[j][2] + v[j][3] * v[j][3]; }
    const float r = rsqrtf(wave_sum(ss) * (1.f / 2048.f) + EPS_);
#pragma unroll
    for (int j = 0; j < 8; ++j) { const f32x4 gv = ((const f32x4*)g)[lane + 64 * j];
        u32x2 w; w.x = pk2(v[j][0] * r * gv[0], v[j][1] * r * gv[1]); w.y = pk2(v[j][2] * r * gv[2], v[j][3] * r * gv[3]);
        ((u32x2*)o)[lane + 64 * j] = w; }
}
__device__ __forceinline__ void post_mix_row(const float* x, const float* mix, const float* g1, const float* g2, float* x1out, bf16_t* h2, int lane) {
    f32x4 v[8]; float ss = 0.f;
#pragma unroll
    for (int j = 0; j < 8; ++j) { v[j] = ((const f32x4*)mix)[lane + 64 * j]; ss += v[j][0] * v[j][0] + v[j][1] * v[j][1] + v[j][2] * v[j][2] + v[j][3] * v[j][3]; }
    const float r = rsqrtf(wave_sum(ss) * (1.f / 2048.f) + EPS_);
    float ss2 = 0.f;
#pragma unroll
    for (int j = 0; j < 8; ++j) { const f32x4 gv = ((const f32x4*)g1)[lane + 64 * j]; const f32x4 xv = ((const f32x4*)x)[lane + 64 * j];
        v[j] = xv + v[j] * r * gv; ((f32x4*)x1out)[lane + 64 * j] = v[j];
        ss2 += v[j][0] * v[j][0] + v[j][1] * v[j][1] + v[j][2] * v[j][2] + v[j][3] * v[j][3]; }
    const float r2 = rsqrtf(wave_sum(ss2) * (1.f / 2048.f) + EPS_);
#pragma unroll
    for (int j = 0; j < 8; ++j) { const f32x4 gv = ((const f32x4*)g2)[lane + 64 * j];
        u32x2 w; w.x = pk2(v[j][0] * r2 * gv[0], v[j][1] * r2 * gv[1]); w.y = pk2(v[j][2] * r2 * gv[2], v[j][3] * r2 * gv[3]);
        ((u32x2*)h2)[lane + 64 * j] = w; }
}
__device__ __forceinline__ void final_row(const float* x1, const float* ffo, const float* g, float* y, int lane) {
    f32x4 v[8]; float ss = 0.f;
#pragma unroll
    for (int j = 0; j < 8; ++j) { v[j] = ((const f32x4*)ffo)[lane + 64 * j]; ss += v[j][0] * v[j][0] + v[j][1] * v[j][1] + v[j][2] * v[j][2] + v[j][3] * v[j][3]; }
    const float r = rsqrtf(wave_sum(ss) * (1.f / 2048.f) + EPS_);
#pragma unroll
    for (int j = 0; j < 8; ++j) { const f32x4 gv = ((const f32x4*)g)[lane + 64 * j]; const f32x4 xv = ((const f32x4*)x1)[lane + 64 * j];
        ((f32x4*)y)[lane + 64 * j] = xv + v[j] * r * gv; }
}

template <class F> __device__ __forceinline__ void skinny_gemm(const bf16_t* A, const bf16_t* Bt, int K, int N, float* red, F store) {
    const int tid = threadIdx.x, wave = tid >> 6, lane = tid & 63, r16 = lane & 15, g = lane >> 4;
    for (int item = blockIdx.x; item < N / 16; item += gridDim.x) {
        const int n0 = item * 16, kper = K >> 3, kb = wave * kper;
        const bf16_t* a0p = A + (size_t)r16 * K + kb + g * 8; const bf16_t* a1p = a0p + (size_t)16 * K;
        const bf16_t* bp = Bt + (size_t)(n0 + r16) * K + kb + g * 8;
        f32x4 c0 = {0.f, 0.f, 0.f, 0.f}, c1 = {0.f, 0.f, 0.f, 0.f};
#pragma unroll 4
        for (int k = 0; k < kper; k += 32) {
            const s16x8 a0 = *(const s16x8*)(a0p + k), a1 = *(const s16x8*)(a1p + k), b = *(const s16x8*)(bp + k);
            c0 = __builtin_amdgcn_mfma_f32_16x16x32_bf16(a0, b, c0, 0, 0, 0); c1 = __builtin_amdgcn_mfma_f32_16x16x32_bf16(a1, b, c1, 0, 0, 0);
            asm volatile("" : "+v"(c0), "+v"(c1) : "v"(a0), "v"(a1), "v"(b)); }
#pragma unroll
        for (int j = 0; j < 4; ++j) { red[wave * 512 + (g * 4 + j) * 16 + r16] = c0[j]; red[wave * 512 + (16 + g * 4 + j) * 16 + r16] = c1[j]; }
        __syncthreads();
        float s = 0.f;
#pragma unroll
        for (int w = 0; w < 8; ++w) s += red[w * 512 + tid];
        store(tid >> 4, n0 + (tid & 15), s);
        __syncthreads();
    }
}
__device__ __forceinline__ void skinny_gu(const bf16_t* A, const bf16_t* Bt, bf16_t* ffs, float* red) {
    const int tid = threadIdx.x, wave = tid >> 6, lane = tid & 63, r16 = lane & 15, g = lane >> 4;
    constexpr int K = 2048;
    for (int item = blockIdx.x; item < DFF / 16; item += gridDim.x) {
        const int n0 = item * 16, kper = K >> 3, kb = wave * kper;
        const int rowg = (n0 / 128) * 256 + (n0 % 128) + r16;
        const bf16_t* a0p = A + (size_t)r16 * K + kb + g * 8; const bf16_t* a1p = a0p + (size_t)16 * K;
        const bf16_t* bgp = Bt + (size_t)rowg * K + kb + g * 8; const bf16_t* bup = bgp + (size_t)128 * K;
        f32x4 c0 = {0.f, 0.f, 0.f, 0.f}, c1 = c0, c2 = c0, c3 = c0;
#pragma unroll 4
        for (int k = 0; k < kper; k += 32) {
            const s16x8 a0 = *(const s16x8*)(a0p + k), a1 = *(const s16x8*)(a1p + k), bg = *(const s16x8*)(bgp + k), bu = *(const s16x8*)(bup + k);
            c0 = __builtin_amdgcn_mfma_f32_16x16x32_bf16(a0, bg, c0, 0, 0, 0); c1 = __builtin_amdgcn_mfma_f32_16x16x32_bf16(a1, bg, c1, 0, 0, 0);
            c2 = __builtin_amdgcn_mfma_f32_16x16x32_bf16(a0, bu, c2, 0, 0, 0); c3 = __builtin_amdgcn_mfma_f32_16x16x32_bf16(a1, bu, c3, 0, 0, 0);
            asm volatile("" : "+v"(c0), "+v"(c1), "+v"(c2), "+v"(c3) : "v"(a0), "v"(a1), "v"(bg), "v"(bu)); }
#pragma unroll
        for (int j = 0; j < 4; ++j) { red[wave * 1024 + (g * 4 + j) * 16 + r16] = c0[j]; red[wave * 1024 + (16 + g * 4 + j) * 16 + r16] = c1[j];
            red[wave * 1024 + 512 + (g * 4 + j) * 16 + r16] = c2[j]; red[wave * 1024 + 512 + (16 + g * 4 + j) * 16 + r16] = c3[j]; }
        __syncthreads();
        float sg = 0.f, su = 0.f;
#pragma unroll
        for (int w = 0; w < 8; ++w) { sg += red[w * 1024 + tid]; su += red[w * 1024 + 512 + tid]; }
        ffs[(size_t)(tid >> 4) * DFF + n0 + (tid & 15)] = f2bf(siluf_(sg) * su);
        __syncthreads();
    }
}

__device__ __forceinline__ void attn_item(const Params& P, int item, int lane) {
    const int r = item & 15, pm = (item >> 4) & 63, h = item >> 10;
    const int q0 = pm * 16, g = lane >> 4, r16 = lane & 15;
    const bf16_t* QC = WS_PTR(const bf16_t, WS_QC); const bf16_t* KC = WS_PTR(const bf16_t, WS_KC); const bf16_t* VT = WS_PTR(const bf16_t, WS_VT);
    s16x8 qf[4];
    { const bf16_t* qb = QC + ((size_t)(h * 16 + r) * 1024 + q0 + r16) * 128 + g * 8;
#pragma unroll
      for (int kk = 0; kk < 4; ++kk) qf[kk] = *(const s16x8*)(qb + 32 * kk); }
    float m_run = -INFINITY, l_run = 0.f;
    f32x4 o[8];
#pragma unroll
    for (int dt = 0; dt < 8; ++dt) o[dt] = (f32x4){0.f, 0.f, 0.f, 0.f};
    for (int rho = 0; rho < 16; ++rho) {
        const int delta = r - rho;
        const int lo = delta < 0 ? 1 : 0;
        const int h1 = (128 - delta) >> 4;
        const int h2 = ((delta & 3) == 0) ? ((512 - delta) >> 4) : -1;
        const int h3 = (delta == 0) ? 128 : -1;
        const int hmax = h3 > 0 ? h3 : (h2 > 0 ? h2 : h1);
        int tile0 = (q0 - hmax) >> 4; if (tile0 < 0) tile0 = 0;
        const bf16_t* Kb = KC + (size_t)(h * 16 + rho) * 1024 * 128 + (size_t)r16 * 128 + g * 8;
        const bf16_t* Vb = VT + (size_t)(h * 16 + rho) * 128 * 1024 + (size_t)r16 * 1024 + 4 * g;
        for (int tile = tile0; tile <= pm; ++tile) {
            const int u0 = tile * 16;
            f32x4 s = {0.f, 0.f, 0.f, 0.f};
            s16x8 kf[4];
#pragma unroll
            for (int kk = 0; kk < 4; ++kk) kf[kk] = *(const s16x8*)(Kb + (size_t)u0 * 128 + 32 * kk);
#pragma unroll
            for (int kk = 0; kk < 4; ++kk) s = __builtin_amdgcn_mfma_f32_16x16x32_bf16(kf[kk], qf[kk], s, 0, 0, 0);
            asm volatile("" : "+v"(s) : "v"(kf[0]), "v"(kf[1]), "v"(kf[2]), "v"(kf[3]));
            s16x4 vf[8];
#pragma unroll
            for (int dt = 0; dt < 8; ++dt) vf[dt] = *(const s16x4*)(Vb + (size_t)dt * 16 * 1024 + u0);
            const int dist = (q0 + r16) - (u0 + 4 * g);
            float mult[4]; float tm = -INFINITY;
#pragma unroll
            for (int i = 0; i < 4; ++i) { const int dd = dist - i;
                const int mu = (dd >= lo) ? ((dd <= h1 ? 1 : 0) + (dd <= h2 ? 1 : 0) + (dd <= h3 ? 1 : 0)) : 0;
                mult[i] = (float)mu; if (mu > 0) tm = fmaxf(tm, s[i]); }
            tm = fmaxf(tm, __shfl_xor(tm, 16)); tm = fmaxf(tm, __shfl_xor(tm, 32));
            const float m_new = fmaxf(m_run, tm);
            if (__any(m_new > m_run)) {
                const float alpha = (m_new == -INFINITY) ? 1.f : exp2f(m_run - m_new);
                l_run *= alpha;
#pragma unroll
                for (int dt = 0; dt < 8; ++dt) o[dt] = o[dt] * alpha;
                m_run = m_new;
            }
            float p[4];
#pragma unroll
            for (int i = 0; i < 4; ++i) { p[i] = (mult[i] > 0.f) ? mult[i] * exp2f(s[i] - m_run) : 0.f; l_run += p[i]; }
            u32x2 pw; pw.x = pk2(p[0], p[1]); pw.y = pk2(p[2], p[3]);
            const s16x4 pb = __builtin_bit_cast(s16x4, pw);
#pragma unroll
            for (int dt = 0; dt < 8; ++dt) o[dt] = __builtin_amdgcn_mfma_f32_16x16x16bf16_1k(vf[dt], pb, o[dt], 0, 0, 0);
        }
    }
    float l = l_run; l += __shfl_xor(l, 16); l += __shfl_xor(l, 32);
    const float inv = 1.f / l;
    const int t = 16 * (q0 + r16) + r;
    bf16_t* op = WS_PTR(bf16_t, WS_OATT) + (size_t)t * 1024 + h * 128 + 4 * g;
#pragma unroll
    for (int dt = 0; dt < 8; ++dt) { const f32x4 v = o[dt] * inv;
        u32x2 w; w.x = pk2(v[0], v[1]); w.y = pk2(v[2], v[3]); *(u32x2*)(op + 16 * dt) = w; }
}

__device__ __forceinline__ int samp_dist(int slot) { return slot < 129 ? slot : (slot < 258 ? 4 * (slot - 129) : 16 * (slot - 258)); }
__device__ __forceinline__ void sattn_item(const Params& P, int item, float* lf) {
    const int tid = threadIdx.x, wave = tid >> 6, b = item >> 3, h = item & 7;
    float* qs = lf; float* sc = lf + 128; float* red = lf + 640; float* po = lf + 704;
    const float* proj = WS_PTR(const float, WS_PROJS) + (size_t)b * NIN;
    if (tid < 128) { qs[tid] = proj[h * 128 + tid] * 0.08838834764831845f;
        P.out[O_WKS + b * 1024 + h * 128 + tid] = proj[1024 + h * 128 + tid]; P.out[O_WVS + b * 1024 + h * 128 + tid] = proj[2048 + h * 128 + tid]; }
    __syncthreads();
    const bool valid = tid < 387; const int d = samp_dist(tid);
    float s = -INFINITY;
    if (valid) { const float* kp = (d == 0) ? (proj + 1024 + h * 128) : (P.cache_k + (((size_t)b * PAST + (PAST - d)) * 8 + h) * 128);
        float a = 0.f;
#pragma unroll 8
        for (int j = 0; j < 32; ++j) { const f32x4 kv = ((const f32x4*)kp)[j]; const f32x4 qv = ((const f32x4*)qs)[j]; a += kv[0] * qv[0] + kv[1] * qv[1] + kv[2] * qv[2] + kv[3] * qv[3]; }
        s = a; }
    float m = s;
#pragma unroll
    for (int o = 1; o < 64; o <<= 1) m = fmaxf(m, __shfl_xor(m, o));
    if ((tid & 63) == 0) red[wave] = m;
    __syncthreads();
    m = red[0];
#pragma unroll
    for (int w = 1; w < 8; ++w) m = fmaxf(m, red[w]);
    const float p = valid ? __expf(s - m) : 0.f;
    sc[tid] = p;
    const float ps = wave_sum(p);
    __syncthreads();
    if ((tid & 63) == 0) red[8 + wave] = ps;
    __syncthreads();
    float tot = 0.f;
#pragma unroll
    for (int w = 0; w < 8; ++w) tot += red[8 + w];
    const int dc = tid & 127, grp = tid >> 7; float acc = 0.f;
    for (int j = grp; j < 387; j += 4) { const int dj = samp_dist(j);
        const float* vp = (dj == 0) ? (proj + 2048 + h * 128) : (P.cache_v + (((size_t)b * PAST + (PAST - dj)) * 8 + h) * 128);
        acc += sc[j] * vp[dc]; }
    po[tid] = acc;
    __syncthreads();
    if (tid < 128) WS_PTR(float, WS_OATTS)[b * 1024 + h * 128 + tid] = (po[tid] + po[tid + 128] + po[tid + 256] + po[tid + 384]) / tot;
    __syncthreads();
}
__device__ __forceinline__ void shgrn_item(const Params& P, int item, float* lf) {
    const int tid = threadIdx.x, wave = tid >> 6, b = item >> 3, h = item & 7;
    float* qv = lf; float* fv = lf + 128; float* kv = lf + 256; float* po = lf + 384; float* red = lf + 896;
    const float* proj = WS_PTR(const float, WS_PROJS) + (size_t)b * NIN;
    if (tid < 128) { const int idx = h * 128 + tid; const float l0 = P.lb_logits[idx], l1 = P.lb_logits[1024 + idx];
        const float lbv = 1.f / (1.f + __expf(l1 - l0)); const float x = proj[4096 + idx];
        fv[tid] = lbv + (1.f - lbv) * sigmoidf_(x); kv[tid] = (1.f - lbv) * sigmoidf_(-x); qv[tid] = siluf_(proj[3072 + idx]); }
    __syncthreads();
    const int v = tid & 127, grp = tid >> 7; const float vv = proj[5120 + h * 128 + v]; float acc = 0.f;
    const size_t sb = ((size_t)(b * 8 + h) * 128) * 128;
#pragma unroll 8
    for (int k = grp * 32; k < grp * 32 + 32; ++k) { const float s = fv[k] * P.state_in[sb + (size_t)k * 128 + v] + kv[k] * vv; P.out[O_STS + sb + (size_t)k * 128 + v] = s; acc += qv[k] * s; }
    po[tid] = acc;
    __syncthreads();
    float o = 0.f;
    if (tid < 128) { o = po[tid] + po[tid + 128] + po[tid + 256] + po[tid + 384]; const float ss = wave_sum(o * o); if ((tid & 63) == 0) red[wave] = ss; }
    __syncthreads();
    if (tid < 128) { const float rstd = rsqrtf((red[0] + red[1]) * (1.f / 128.f) + EPS_);
        WS_PTR(float, WS_OHGS)[b * 1024 + h * 128 + tid] = o * rstd * P.hg_gain[tid] * siluf_(proj[6144 + h * 128 + tid]); }
    __syncthreads();
}

template <bool OUT> __device__ __forceinline__ void hgrn_item(const Params& P, int item, unsigned char* lds) {
    const int tid = threadIdx.x, wave = tid >> 6, lane = tid & 63, g = lane >> 4, r16 = lane & 15;
    const int h = item / NCH, c = item % NCH, t0 = c * 64;
    bf16_t* Qs = (bf16_t*)lds; bf16_t* Ks = (bf16_t*)(lds + 17408); bf16_t* KHt = (bf16_t*)(lds + 34816); bf16_t* Vt = (bf16_t*)(lds + 51200);
    float* Ds = (float*)(lds + 67584); float* Os = (float*)(lds + 69632);
    const bf16_t* HG = WS_PTR(const bf16_t, WS_HG);
    {
        const int k = tid & 127, sb = tid >> 7;
        const bf16_t* hg = HG + (size_t)(t0 + sb * 16) * 4096 + h * 128 + k;
        const float l0 = P.lb_logits[h * 128 + k], l1 = P.lb_logits[1024 + h * 128 + k];
        const float lbk = 1.f / (1.f + __expf(l1 - l0));
        float cums[16], kvv[16]; float cum = 0.f;
#pragma unroll
        for (int t = 0; t < 16; ++t) { const float x = bf2f(hg[(size_t)t * 4096 + 1024]); const float f = lbk + (1.f - lbk) * sigmoidf_(x);
            cum += __logf(f); cums[t] = cum; kvv[t] = (1.f - lbk) * sigmoidf_(-x); }
        unsigned khp[8], vtp[8];
#pragma unroll
        for (int t = 0; t < 16; t += 2) {
            const float qa = siluf_(bf2f(hg[(size_t)t * 4096])), qb = siluf_(bf2f(hg[(size_t)(t + 1) * 4096]));
            Qs[(sb * 16 + t) * 136 + k] = f2bf(qa * __expf(cums[t])); Qs[(sb * 16 + t + 1) * 136 + k] = f2bf(qb * __expf(cums[t + 1]));
            Ks[(sb * 16 + t) * 136 + k] = f2bf(kvv[t] * __expf(-cums[t])); Ks[(sb * 16 + t + 1) * 136 + k] = f2bf(kvv[t + 1] * __expf(-cums[t + 1]));
            khp[t >> 1] = pk2(kvv[t] * __expf(cum - cums[t]), kvv[t + 1] * __expf(cum - cums[t + 1]));
            vtp[t >> 1] = (unsigned)hg[(size_t)t * 4096 + 2048] | ((unsigned)hg[(size_t)(t + 1) * 4096 + 2048] << 16);
        }
        u32x4* kd = (u32x4*)(KHt + (sb * 128 + k) * 16); kd[0] = (u32x4){khp[0], khp[1], khp[2], khp[3]}; kd[1] = (u32x4){khp[4], khp[5], khp[6], khp[7]};
        u32x4* vd = (u32x4*)(Vt + (sb * 128 + k) * 16); vd[0] = (u32x4){vtp[0], vtp[1], vtp[2], vtp[3]}; vd[1] = (u32x4){vtp[4], vtp[5], vtp[6], vtp[7]};
        Ds[sb * 128 + k] = __expf(cum);
    }
    __syncthreads();
    f32x4 S[8];
    float* Ub = WS_PTR(float, WS_U) + ((size_t)(c * 8 + h) * 128) * 128 + 16 * wave + r16;
#pragma unroll
    for (int kt = 0; kt < 8; ++kt) {
        if (OUT && MK_VAR != 1) {
#pragma unroll
            for (int i = 0; i < 4; ++i) S[kt][i] = Ub[(size_t)(16 * kt + 4 * g + i) * 128];
        } else S[kt] = (f32x4){0.f, 0.f, 0.f, 0.f};
    }
    for (int sb = 0; sb < 4; ++sb) {
        const s16x4 vA = *(const s16x4*)(Vt + (sb * 128 + 16 * wave + r16) * 16 + 4 * g);
        if (OUT) {
            s16x8 qB[4], kA[4];
#pragma unroll
            for (int kk = 0; kk < 4; ++kk) {
                const s16x4 ql = *(const s16x4*)(Qs + (sb * 16 + r16) * 136 + 32 * kk + 4 * g), qh = *(const s16x4*)(Qs + (sb * 16 + r16) * 136 + 32 * kk + 16 + 4 * g);
                qB[kk] = __builtin_shufflevector(ql, qh, 0, 1, 2, 3, 4, 5, 6, 7);
                const s16x4 kl = *(const s16x4*)(Ks + (sb * 16 + r16) * 136 + 32 * kk + 4 * g), kh = *(const s16x4*)(Ks + (sb * 16 + r16) * 136 + 32 * kk + 16 + 4 * g);
                kA[kk] = __builtin_shufflevector(kl, kh, 0, 1, 2, 3, 4, 5, 6, 7);
            }
            f32x4 oT = {0.f, 0.f, 0.f, 0.f}, aT = {0.f, 0.f, 0.f, 0.f};
#pragma unroll
            for (int kk = 0; kk < 4; ++kk) {
                u32x4 sw; sw.x = pk2(S[2 * kk][0], S[2 * kk][1]); sw.y = pk2(S[2 * kk][2], S[2 * kk][3]); sw.z = pk2(S[2 * kk + 1][0], S[2 * kk + 1][1]); sw.w = pk2(S[2 * kk + 1][2], S[2 * kk + 1][3]);
                const s16x8 sA = __builtin_bit_cast(s16x8, sw);
                oT = __builtin_amdgcn_mfma_f32_16x16x32_bf16(sA, qB[kk], oT, 0, 0, 0);
                aT = __builtin_amdgcn_mfma_f32_16x16x32_bf16(kA[kk], qB[kk], aT, 0, 0, 0);
                asm volatile("" : "+v"(oT), "+v"(aT) : "v"(sA), "v"(qB[kk]), "v"(kA[kk]));
            }
            SETTLE();
#pragma unroll
            for (int i = 0; i < 4; ++i) if (4 * g + i > r16) aT[i] = 0.f;
            u32x2 aw; aw.x = pk2(aT[0], aT[1]); aw.y = pk2(aT[2], aT[3]);
#if MK_SUB != 1
            oT = __builtin_amdgcn_mfma_f32_16x16x16bf16_1k(vA, __builtin_bit_cast(s16x4, aw), oT, 0, 0, 0);
#else
            if (aw.x == 0x12345678u && aw.y == 0x9abcdef1u) oT[0] += 1.f;
#endif
            SETTLE();
            *(f32x4*)(Os + (sb * 16 + r16) * 132 + 16 * wave + 4 * g) = oT;
#if MK_VAR == 4
            { u32x2 w; w.x = pk2(oT[0], oT[1]); w.y = pk2(oT[2], oT[3]);
              *(u32x2*)(WS_PTR(bf16_t, WS_MRG) + (size_t)(t0 + sb * 16 + r16) * 2048 + 1024 + h * 128 + 16 * wave + 4 * g) = w; }
#endif
        }
#pragma unroll
        for (int kt = 0; kt < 8; ++kt) {
            const f32x4 d4 = *(const f32x4*)(Ds + sb * 128 + 16 * kt + 4 * g);
            const s16x4 khA = *(const s16x4*)(KHt + (sb * 128 + 16 * kt + r16) * 16 + 4 * g);
            S[kt] = __builtin_amdgcn_mfma_f32_16x16x16bf16_1k(khA, vA, S[kt] * d4, 0, 0, 0);
        }
        SETTLE();
    }
    if (!OUT) {
#pragma unroll
        for (int kt = 0; kt < 8; ++kt)
#pragma unroll
            for (int i = 0; i < 4; ++i) Ub[(size_t)(16 * kt + 4 * g + i) * 128] = S[kt][i];
        if (tid < 128) WS_PTR(float, WS_DD)[(size_t)(c * 8 + h) * 128 + tid] = Ds[tid] * Ds[128 + tid] * Ds[256 + tid] * Ds[384 + tid];
    } else {
        __syncthreads();
        const int t = tid >> 3, j = tid & 7;
        const float* orow = Os + t * 132 + 16 * j;
        f32x4 ov[4]; float ss = 0.f;
#pragma unroll
        for (int q = 0; q < 4; ++q) { ov[q] = ((const f32x4*)orow)[q]; ss += ov[q][0] * ov[q][0] + ov[q][1] * ov[q][1] + ov[q][2] * ov[q][2] + ov[q][3] * ov[q][3]; }
        ss += __shfl_xor(ss, 1); ss += __shfl_xor(ss, 2); ss += __shfl_xor(ss, 4);
        const float rstd = rsqrtf(ss * (1.f / 128.f) + EPS_);
        const u32x4* gp = (const u32x4*)(HG + (size_t)(t0 + t) * 4096 + 3072 + h * 128 + 16 * j);
        const u32x4 ga = gp[0], gb = gp[1];
        const unsigned gw[8] = {ga.x, ga.y, ga.z, ga.w, gb.x, gb.y, gb.z, gb.w};
        unsigned ow[8];
#pragma unroll
        for (int q = 0; q < 4; ++q) { const f32x4 gn = ((const f32x4*)(P.hg_gain + 16 * j))[q];
            const float a0 = ov[q][0] * rstd * gn[0] * siluf_(bflo(gw[2 * q])), a1 = ov[q][1] * rstd * gn[1] * siluf_(bfhi(gw[2 * q]));
            const float a2 = ov[q][2] * rstd * gn[2] * siluf_(bflo(gw[2 * q + 1])), a3 = ov[q][3] * rstd * gn[3] * siluf_(bfhi(gw[2 * q + 1]));
            ow[2 * q] = pk2(a0, a1); ow[2 * q + 1] = pk2(a2, a3); }
        u32x4* mp = (u32x4*)(WS_PTR(bf16_t, WS_MRG) + (size_t)(t0 + t) * 2048 + 1024 + h * 128 + 16 * j);
#if MK_VAR != 4
        mp[0] = (u32x4){ow[0], ow[1], ow[2], ow[3]}; mp[1] = (u32x4){ow[4], ow[5], ow[6], ow[7]};
#else
        if (ow[0] == 0x12345678u && ow[7] == 0x9abcdef0u) mp[0] = (u32x4){ow[0], ow[1], ow[2], ow[3]};
#endif
    }
    __syncthreads();
}

__device__ __forceinline__ void phase_run(const Params& P, int ph, unsigned char* lds) {
    const int tid = threadIdx.x, wave = tid >> 6, lane = tid & 63;
    const int gw = blockIdx.x * 8 + wave, NGW = gridDim.x * 8;
    float* lf = (float*)lds;
    pg8::StaticOrder SO;
#ifdef ONLY_PH
    if (ph != ONLY_PH) return; ph = ONLY_PH;
#endif
    switch (ph) {
    case 0: {
        float* scr = (float*)(lds + wave * 8448);
        constexpr int I_IN = 32 * 224, I_OUT = 32 * 64, I_G = 32 * 176, I_D = 88 * 64;
        for (int it = gw; it < I_IN + I_OUT + 2 * I_G + I_D; it += NGW) {
            int r = it;
            if (r < I_IN) { transpose_item(P.w_in, 2048, NIN, WS_PTR(bf16_t, WS_WIN), 1 << 20, 0, 0, scr, r, lane); continue; } r -= I_IN;
            if (r < I_OUT) { transpose_item(P.w_out, 2048, 2048, WS_PTR(bf16_t, WS_WOUT), 1 << 20, 0, 0, scr, r, lane); continue; } r -= I_OUT;
            if (r < I_G) { transpose_item(P.w_gate, 2048, DFF, WS_PTR(bf16_t, WS_WGU), 128, 256, 0, scr, r, lane); continue; } r -= I_G;
            if (r < I_G) { transpose_item(P.w_up, 2048, DFF, WS_PTR(bf16_t, WS_WGU), 128, 256, 128, scr, r, lane); continue; } r -= I_G;
            transpose_item(P.w_down, DFF, 2048, WS_PTR(bf16_t, WS_WD), 1 << 20, 0, 0, scr, r, lane);
        }
        for (int row = gw; row < T_ + NBS; row += NGW) {
            if (row < T_) rms_row_bf16(P.x_prompt + (size_t)row * 2048, P.n_pre_mix, WS_PTR(bf16_t, WS_H) + (size_t)row * 2048, lane);
            else rms_row_bf16(P.x_sample + (size_t)(row - T_) * 2048, P.n_pre_mix, WS_PTR(bf16_t, WS_HS) + (size_t)(row - T_) * 2048, lane);
        }
    } break;
    case 1: {
        float* projs = WS_PTR(float, WS_PROJS);
        skinny_gemm(WS_PTR(const bf16_t, WS_HS), WS_PTR(const bf16_t, WS_WIN), 2048, NIN, lf, [=](int row, int col, float v) { projs[(size_t)row * NIN + col] = v; });
        pg8::Gemm gm{WS_PTR(const bf16_t, WS_H), WS_PTR(const bf16_t, WS_WIN), T_, NIN, 2048};
        SO.init(T_, NIN, (int)gridDim.x, (int)blockIdx.x);
        EpiIn E{WS_PTR(bf16_t, WS_QC), WS_PTR(bf16_t, WS_KC), WS_PTR(bf16_t, WS_VT), WS_PTR(bf16_t, WS_HG), P.out + O_WKP, P.out + O_WVP, 0.08838834764831845f * 1.4426950408889634f};
        pg8::gemm_phase<EpiIn, pg8::StaticOrder, false>((PG8_LAS unsigned char*)lds, gm, SO, E, nullptr);
    } break;
    case 2: {
        for (int it = blockIdx.x; it < 256; it += gridDim.x) { sattn_item(P, it, lf); shgrn_item(P, it, lf); }
        for (int it = blockIdx.x; it < 8 * NCH; it += gridDim.x) hgrn_item<false>(P, it, lds);
        for (int it = gw; it < 8192; it += NGW) attn_item(P, it, lane);
    } break;
    case 3: {
        float* U = WS_PTR(float, WS_U); const float* DD = WS_PTR(const float, WS_DD);
        for (int e = blockIdx.x * 512 + tid; e < 8 * 128 * 128; e += gridDim.x * 512) {
            const int hk = e >> 7; float S = 0.f;
#pragma unroll 8
            for (int c = 0; c < NCH; ++c) { const float u = U[(size_t)c * 131072 + e]; const float d = DD[c * 1024 + hk]; U[(size_t)c * 131072 + e] = S; S = d * S + u; }
            P.out[O_STP + e] = S;
        }
        if (gw < NBS) {
            const float* oa = WS_PTR(const float, WS_OATTS) + gw * 1024; const float* oh = WS_PTR(const float, WS_OHGS) + gw * 1024; bf16_t* mr = WS_PTR(bf16_t, WS_MRGS) + gw * 2048;
            f32x4 v[4]; float ss = 0.f;
#pragma unroll
            for (int j = 0; j < 4; ++j) { v[j] = ((const f32x4*)oa)[lane + 64 * j]; ss += v[j][0] * v[j][0] + v[j][1] * v[j][1] + v[j][2] * v[j][2] + v[j][3] * v[j][3]; }
            const float r = rsqrtf(wave_sum(ss) * (1.f / 1024.f) + EPS_);
#pragma unroll
            for (int j = 0; j < 4; ++j) { const f32x4 gv = ((const f32x4*)P.attn_gain)[lane + 64 * j]; const f32x4 hv = ((const f32x4*)oh)[lane + 64 * j];
                u32x2 w; w.x = pk2(v[j][0] * r * gv[0], v[j][1] * r * gv[1]); w.y = pk2(v[j][2] * r * gv[2], v[j][3] * r * gv[3]); ((u32x2*)mr)[lane + 64 * j] = w;
                u32x2 w2; w2.x = pk2(hv[0], hv[1]); w2.y = pk2(hv[2], hv[3]); ((u32x2*)(mr + 1024))[lane + 64 * j] = w2; }
        }
    } break;
    case 4: {
        float* mixs = WS_PTR(float, WS_MIXS);
        skinny_gemm(WS_PTR(const bf16_t, WS_MRGS), WS_PTR(const bf16_t, WS_WOUT), 2048, 2048, lf, [=](int row, int col, float v) { mixs[(size_t)row * 2048 + col] = v; });
        for (int it = blockIdx.x; it < 8 * NCH; it += gridDim.x) hgrn_item<true>(P, it, lds);
        for (int row = gw; row < T_; row += NGW) {
            const u32x4* ip = (const u32x4*)(WS_PTR(const bf16_t, WS_OATT) + (size_t)row * 1024) + lane * 2;
            float ss = 0.f;
#pragma unroll
            for (int q = 0; q < 2; ++q) { const u32x4 w = ip[q];
                ss += bflo(w.x) * bflo(w.x) + bfhi(w.x) * bfhi(w.x) + bflo(w.y) * bflo(w.y) + bfhi(w.y) * bfhi(w.y) + bflo(w.z) * bflo(w.z) + bfhi(w.z) * bfhi(w.z) + bflo(w.w) * bflo(w.w) + bfhi(w.w) * bfhi(w.w); }
            const float r = rsqrtf(wave_sum(ss) * (1.f / 1024.f) + EPS_);
            u32x4* op = (u32x4*)(WS_PTR(bf16_t, WS_MRG) + (size_t)row * 2048) + lane * 2;
#pragma unroll
            for (int q = 0; q < 2; ++q) { const u32x4 w = ip[q]; const f32x4 g0 = ((const f32x4*)P.attn_gain)[lane * 4 + q * 2], g1 = ((const f32x4*)P.attn_gain)[lane * 4 + q * 2 + 1];
                u32x4 o; o.x = pk2(bflo(w.x) * r * g0[0], bfhi(w.x) * r * g0[1]); o.y = pk2(bflo(w.y) * r * g0[2], bfhi(w.y) * r * g0[3]);
                o.z = pk2(bflo(w.z) * r * g1[0], bfhi(w.z) * r * g1[1]); o.w = pk2(bflo(w.w) * r * g1[2], bfhi(w.w) * r * g1[3]); op[q] = o; }
        }
    } break;
    case 5: {
        if (gw < NBS) post_mix_row(P.x_sample + (size_t)gw * 2048, WS_PTR(const float, WS_MIXS) + (size_t)gw * 2048, P.n_post_mix, P.n_pre_ffn, P.out + O_YS + (size_t)gw * 2048, WS_PTR(bf16_t, WS_H2S) + (size_t)gw * 2048, lane);
        pg8::Gemm gm{WS_PTR(const bf16_t, WS_MRG), WS_PTR(const bf16_t, WS_WOUT), T_, 2048, 2048};
        SO.init(T_, 2048, (int)gridDim.x, (int)blockIdx.x);
        EpiF32 E{WS_PTR(float, WS_MIX), 2048};
        pg8::gemm_phase<EpiF32, pg8::StaticOrder, false>((PG8_LAS unsigned char*)lds, gm, SO, E, nullptr);
    } break;
    case 6: {
        skinny_gu(WS_PTR(const bf16_t, WS_H2S), WS_PTR(const bf16_t, WS_WGU), WS_PTR(bf16_t, WS_FFS), lf);
#if MK_DBG == 1
        for (int row = gw; row < T_; row += NGW) for (int c = lane; c < 2048; c += 64) P.out[O_YP + (size_t)row * 2048 + c] = bf2f(WS_PTR(const bf16_t, WS_MRG)[(size_t)row * 2048 + c]);
#elif MK_DBG == 4
        for (int row = gw; row < T_; row += NGW) for (int c = lane; c < 2048; c += 64) P.out[O_YP + (size_t)row * 2048 + c] = bf2f(WS_PTR(const bf16_t, WS_HG)[(size_t)row * 4096 + c]);
#elif MK_DBG == 5
        for (int row = gw; row < T_; row += NGW) for (int c = lane; c < 2048; c += 64) P.out[O_YP + (size_t)row * 2048 + c] = (c >= 1024) ? 0.f : bf2f(WS_PTR(const bf16_t, WS_OATT)[(size_t)row * 1024 + c]);
#elif MK_DBG == 6
        for (size_t i = (size_t)blockIdx.x * 512 + tid; i < (size_t)T_ * 2048; i += (size_t)gridDim.x * 512) P.out[O_YP + i] = WS_PTR(const float, WS_U)[i];
#elif MK_DBG == 7
        for (int row = gw; row < T_; row += NGW) for (int c = lane; c < 2048; c += 64) P.out[O_YP + (size_t)row * 2048 + c] = bf2f(WS_PTR(const bf16_t, WS_HG)[(size_t)row * 4096 + 2048 + c]);
#elif MK_DBG == 2
        for (int row = gw; row < T_; row += NGW) for (int c = lane; c < 2048; c += 64) P.out[O_YP + (size_t)row * 2048 + c] = (c < 1024) ? 0.f : bf2f(WS_PTR(const bf16_t, WS_MRG)[(size_t)row * 2048 + c]);
#else
        for (int row = gw; row < T_; row += NGW)
            post_mix_row(P.x_prompt + (size_t)row * 2048, WS_PTR(const float, WS_MIX) + (size_t)row * 2048, P.n_post_mix, P.n_pre_ffn, P.out + O_YP + (size_t)row * 2048, WS_PTR(bf16_t, WS_H) + (size_t)row * 2048, lane);
#endif
    } break;
    case 7: {
        float* ffos = WS_PTR(float, WS_FFOS);
        skinny_gemm(WS_PTR(const bf16_t, WS_FFS), WS_PTR(const bf16_t, WS_WD), DFF, 2048, lf, [=](int row, int col, float v) { ffos[(size_t)row * 2048 + col] = v; });
        pg8::Gemm gm{WS_PTR(const bf16_t, WS_H), WS_PTR(const bf16_t, WS_WGU), T_, 2 * DFF, 2048};
        SO.init(T_, 2 * DFF, (int)gridDim.x, (int)blockIdx.x);
        EpiSwiGLU E{WS_PTR(bf16_t, WS_FF)};
        pg8::gemm_phase<EpiSwiGLU, pg8::StaticOrder, false>((PG8_LAS unsigned char*)lds, gm, SO, E, nullptr);
    } break;
    case 8: {
        if (gw < NBS) final_row(P.out + O_YS + (size_t)gw * 2048, WS_PTR(const float, WS_FFOS) + (size_t)gw * 2048, P.n_post_ffn, P.out + O_YS + (size_t)gw * 2048, lane);
        pg8::Gemm gm{WS_PTR(const bf16_t, WS_FF), WS_PTR(const bf16_t, WS_WD), T_, 2048, DFF};
        SO.init(T_, 2048, (int)gridDim.x, (int)blockIdx.x);
        EpiF32 E{WS_PTR(float, WS_MIX), 2048};
        pg8::gemm_phase<EpiF32, pg8::StaticOrder, false>((PG8_LAS unsigned char*)lds, gm, SO, E, nullptr);
    } break;
    case 9: {
        for (int row = gw; row < T_; row += NGW)
            final_row(P.out + O_YP + (size_t)row * 2048, WS_PTR(const float, WS_MIX) + (size_t)row * 2048, P.n_post_ffn, P.out + O_YP + (size_t)row * 2048, lane);
    } break;
    default: break;
    }
}

__global__ __launch_bounds__(512, 2) void hymba_fwd(Params P) {
    extern __shared__ __attribute__((aligned(16))) unsigned char shm[];
    cg::grid_group grid = cg::this_grid();
#ifdef TEST_NOLOOP
    phase_run(P, ONLY_PH, shm);
#else
#define RUN_PH(n) if (P.ph_lo <= n && n < P.ph_hi) { phase_run(P, n, shm); if (n + 1 < P.ph_hi) grid.sync(); }
    RUN_PH(0) RUN_PH(1) RUN_PH(2) RUN_PH(3) RUN_PH(4) RUN_PH(5) RUN_PH(6) RUN_PH(7) RUN_PH(8) RUN_PH(9)
#endif
}

extern "C" void kernel_launch(void* const* d_in, const int* in_sizes, int n_in, void* d_out, int out_size, void* d_ws, size_t ws_size, hipStream_t stream) {
    static int grid = 0;
    if (grid == 0) {
        if (ws_size < WS_END) { fprintf(stderr, "kernel_launch: workspace too small (%zu < %zu)\n", ws_size, (size_t)WS_END); grid = -1; return; }
        int dev = 0, cus = 0, per_cu = 0;
        hipGetDevice(&dev);
        hipDeviceGetAttribute(&cus, hipDeviceAttributeMultiprocessorCount, dev);
        if (hipFuncSetAttribute((const void*)hymba_fwd, hipFuncAttributeMaxDynamicSharedMemorySize, LDS_BYTES) != hipSuccess) { fprintf(stderr, "kernel_launch: hipFuncSetAttribute failed\n"); grid = -1; return; }
        if (hipOccupancyMaxActiveBlocksPerMultiprocessor(&per_cu, (const void*)hymba_fwd, 512, LDS_BYTES) != hipSuccess || per_cu < 1) { fprintf(stderr, "kernel_launch: occupancy query says %d\n", per_cu); per_cu = 1; }
        (void)hipGetLastError();
        grid = cus;
    }
    if (grid < 0) return;
    Params p{};
    p.x_prompt = (const float*)d_in[0]; p.x_sample = (const float*)d_in[1]; p.cache_k = (const float*)d_in[2]; p.cache_v = (const float*)d_in[3]; p.state_in = (const float*)d_in[4];
    p.n_pre_mix = (const float*)d_in[5]; p.w_in = (const float*)d_in[6]; p.lb_logits = (const float*)d_in[7]; p.attn_gain = (const float*)d_in[8]; p.hg_gain = (const float*)d_in[9];
    p.w_out = (const float*)d_in[10]; p.n_post_mix = (const float*)d_in[11]; p.n_pre_ffn = (const float*)d_in[12]; p.w_gate = (const float*)d_in[13]; p.w_up = (const float*)d_in[14];
    p.w_down = (const float*)d_in[15]; p.n_post_ffn = (const float*)d_in[16];
    p.out = (float*)d_out; p.ws = (unsigned char*)d_ws;
#if MK_FUSED
    p.ph_lo = 0; p.ph_hi = 10;
    { void* args[] = {&p}; hipError_t e = hipLaunchCooperativeKernel((const void*)hymba_fwd, dim3(grid), dim3(512), args, LDS_BYTES, stream);
      if (e != hipSuccess) fprintf(stderr, "cooperative launch failed: %s (grid %d)\n", hipGetErrorString(e), grid); }
#else
    for (int ph = 0; ph < MK_NPH; ++ph) { p.ph_lo = ph; p.ph_hi = ph + 1; void* args[] = {&p};
      hipError_t e = hipLaunchCooperativeKernel((const void*)hymba_fwd, dim3(grid), dim3(512), args, LDS_BYTES, stream);
      if (e != hipSuccess) fprintf(stderr, "launch %d failed: %s (grid %d)\n", ph, hipGetErrorString(e), grid); }
#endif
}
```

```cpp
#include <hip/hip_runtime.h>
#include <hip/hip_cooperative_groups.h>
#include <cstdio>
namespace cg = cooperative_groups;

#ifndef MK_SETTLE
#define MK_SETTLE 0
#endif
#ifndef MK_VAR
#define MK_VAR 0
#endif
#ifndef MK_SUB
#define MK_SUB 0
#endif
#ifndef MK_TIMER
#define MK_TIMER 0
#define MK_T1 (d[0])
#define MK_T2 (d[3])
#endif
#ifndef MK_ATTPROBE
#define MK_ATTPROBE 0
#endif
#ifndef MK_XSYNC
#define MK_XSYNC 0
#endif
#ifndef MK_CGSEAM
#define MK_CGSEAM (-1)
#endif
#ifndef MK_STAG
#define MK_STAG 0
#endif
#ifndef MK_DBG
#define MK_DBG 0
#endif
#ifndef MK_NPH
#define MK_NPH 10
#endif
#ifndef MK_FUSED
#define MK_FUSED 1
#endif

typedef unsigned short bf16_t;
typedef short s16x8 __attribute__((ext_vector_type(8)));
typedef short s16x4 __attribute__((ext_vector_type(4)));
typedef float f32x4 __attribute__((ext_vector_type(4)));
typedef unsigned u32x4 __attribute__((ext_vector_type(4)));
typedef unsigned u32x2 __attribute__((ext_vector_type(2)));

constexpr int T_ = 16384, D_ = 2048, NIN = 7168, DFF = 5632, NBS = 32, PAST = 2048;
constexpr int NCH = 64;
constexpr float EPS_ = 1e-6f;
constexpr int LDS_BYTES = 131072 + 256;

constexpr size_t WS_WIN = 0;
constexpr size_t WS_WOUT = WS_WIN + (size_t)NIN * D_ * 2;
constexpr size_t WS_WGU = WS_WOUT + (size_t)D_ * D_ * 2;
constexpr size_t WS_WD = WS_WGU + (size_t)2 * DFF * D_ * 2;
constexpr size_t WS_H = WS_WD + (size_t)D_ * DFF * 2;
constexpr size_t WS_QC = WS_H + (size_t)T_ * D_ * 2;
constexpr size_t WS_KC = WS_QC + (size_t)T_ * 1024 * 2;
constexpr size_t WS_VT = WS_KC + (size_t)T_ * 1024 * 2;
constexpr size_t WS_HG = WS_VT + (size_t)T_ * 1024 * 2;
constexpr size_t WS_FF = WS_QC;
constexpr size_t WS_OATT = WS_HG + (size_t)T_ * 4096 * 2;
constexpr size_t WS_U = WS_OATT + (size_t)T_ * 1024 * 2;
constexpr size_t WS_DD = WS_U + (size_t)NCH * 8 * 128 * 128 * 4;
constexpr size_t WS_MRG = WS_DD + (size_t)NCH * 1024 * 4;
constexpr size_t WS_MIX = WS_MRG + (size_t)T_ * D_ * 2;
constexpr size_t WS_SSQ = WS_MIX + (size_t)T_ * D_ * 4;
constexpr size_t WS_S0 = WS_SSQ + (size_t)T_ * 4;
constexpr size_t WS_HS = WS_S0;
constexpr size_t WS_PROJS = WS_HS + 32 * 2048 * 2;
constexpr size_t WS_OATTS = WS_PROJS + 32 * 7168 * 4;
constexpr size_t WS_OHGS = WS_OATTS + 32 * 1024 * 4;
constexpr size_t WS_MRGS = WS_OHGS + 32 * 1024 * 4;
constexpr size_t WS_MIXS = WS_MRGS + 32 * 2048 * 2;
constexpr size_t WS_H2S = WS_MIXS + 32 * 2048 * 4;
constexpr size_t WS_FFS = WS_H2S + 32 * 2048 * 2;
constexpr size_t WS_FFOS = WS_FFS + 32 * 5632 * 2;
constexpr size_t WS_BAR = WS_FFOS + 32 * 2048 * 4;
constexpr size_t WS_END = WS_BAR + 3456 * 4 + 256;

constexpr size_t O_YP = 0;
constexpr size_t O_YS = O_YP + (size_t)T_ * D_;
constexpr size_t O_WKP = O_YS + 32 * 2048;
constexpr size_t O_WVP = O_WKP + (size_t)2048 * 1024;
constexpr size_t O_STP = O_WVP + (size_t)2048 * 1024;
constexpr size_t O_WKS = O_STP + 8 * 128 * 128;
constexpr size_t O_WVS = O_WKS + 32 * 1024;
constexpr size_t O_STS = O_WVS + 32 * 1024;

struct Params {
    const float* x_prompt; const float* x_sample; const float* cache_k; const float* cache_v; const float* state_in;
    const float* n_pre_mix; const float* w_in; const float* lb_logits; const float* attn_gain; const float* hg_gain;
    const float* w_out; const float* n_post_mix; const float* n_pre_ffn; const float* w_gate; const float* w_up;
    const float* w_down; const float* n_post_ffn;
    float* out; unsigned char* ws;
    int ph_lo, ph_hi;
};

typedef __bf16 bf16x2v_ __attribute__((ext_vector_type(2)));
typedef float f32x2v_ __attribute__((ext_vector_type(2)));
__device__ __forceinline__ unsigned pk2(float lo, float hi) { const f32x2v_ f = {lo, hi}; const bf16x2v_ b = __builtin_convertvector(f, bf16x2v_); return __builtin_bit_cast(unsigned, b); }
__device__ __forceinline__ bf16_t f2bf(float f) { unsigned u = __float_as_uint(f); u += 0x7FFFu + ((u >> 16) & 1u); return (bf16_t)(u >> 16); }
__device__ __forceinline__ float bf2f(bf16_t b) { return __uint_as_float(((unsigned)b) << 16); }
__device__ __forceinline__ float bflo(unsigned w) { return __uint_as_float(w << 16); }
__device__ __forceinline__ float bfhi(unsigned w) { return __uint_as_float(w & 0xffff0000u); }
__device__ __forceinline__ float wave_sum(float v) {
#pragma unroll
    for (int o = 1; o < 64; o <<= 1) v += __shfl_xor(v, o);
    return v;
}
__device__ __forceinline__ float sigmoidf_(float x) { return __builtin_amdgcn_rcpf(1.f + __expf(-x)); }
__device__ __forceinline__ float siluf_(float x) { return x * __builtin_amdgcn_rcpf(1.f + __expf(-x)); }

#define XB_TMO      128
#define XB_XCNT(j)  (256  + 64 * (j))
#define XB_XSUB(j)  (1280 + 64 * (j))
#define XB_XGEN(j)  (2304 + 64 * (j))
#define XB_TOP      3328
#define XB_TOPGEN   3392
#define XCD_BAR_WORDS 3456
#define XB_SPIN_CAP (1u << 18)
#define LAS __attribute__((address_space(3)))

__device__ __forceinline__ unsigned xb_ld(unsigned* p)              { return __hip_atomic_load(p, __ATOMIC_RELAXED, __HIP_MEMORY_SCOPE_AGENT); }
__device__ __forceinline__ unsigned xb_add(unsigned* p, unsigned v) { return __hip_atomic_fetch_add(p, v, __ATOMIC_RELAXED, __HIP_MEMORY_SCOPE_AGENT); }
__device__ __forceinline__ unsigned xb_xcc_id() { return (unsigned)__builtin_amdgcn_s_getreg((3 << 11) | 20) & 0xFu; }
#define XB_SPIN(cond, bar) do { unsigned _sp = 0; while (cond) { __builtin_amdgcn_s_sleep(1); \
    if ((++_sp & 255u) == 0u) { if (xb_ld(&(bar)[XB_TMO])) break; if (_sp > XB_SPIN_CAP) { atomicAdd(&(bar)[XB_TMO], 1u); break; } } } } while (0)

struct XcdBarrier {
    unsigned* bar; unsigned x;
    volatile LAS unsigned* st;
};

__device__ __forceinline__ XcdBarrier xcd_barrier_post(unsigned* bar, volatile LAS unsigned* st) {
    XcdBarrier b; b.bar = bar; b.x = xb_xcc_id(); b.st = st;
    if (threadIdx.x == 0) (void)xb_add(&bar[XB_XCNT(b.x)], 1u);
    return b;
}
__device__ __forceinline__ void xcd_barrier_complete(unsigned* bar, unsigned x, unsigned& nloc, unsigned& nx) {
    const unsigned G = gridDim.x * gridDim.y * gridDim.z;
    unsigned sum, cnt, mine, sp = 0u;
    for (;;) {
        sum = 0u; cnt = 0u; mine = 0u;
#pragma unroll
        for (unsigned j = 0; j < 16; ++j) { const unsigned c = xb_ld(&bar[XB_XCNT(j)]); sum += c; cnt += (c > 0u) ? 1u : 0u; mine = (j == x) ? c : mine; }
        if (sum == G) break;
        __builtin_amdgcn_s_sleep(1);
        if ((++sp & 255u) == 0u) { if (xb_ld(&bar[XB_TMO])) break; if (sp > XB_SPIN_CAP) { atomicAdd(&bar[XB_TMO], 1u); break; } }
    }
    nloc = mine > 0u ? mine : 1u; nx = cnt > 0u ? cnt : 1u;
}

__device__ __forceinline__ void xcd_barrier(const XcdBarrier& b) {
    asm volatile("s_waitcnt vmcnt(0)" ::: "memory");
    __syncthreads();
    if (threadIdx.x == 0) {
        unsigned* bar = b.bar;
        __builtin_amdgcn_s_waitcnt(0);
        unsigned nloc = b.st[0], nx = b.st[1];
        if (nloc == 0u) { xcd_barrier_complete(bar, b.x, nloc, nx); b.st[0] = nloc; b.st[1] = nx; }
        const unsigned old = xb_add(&bar[XB_XSUB(b.x)], 1u);
        const unsigned gen = old / nloc;
        if (old + 1u == (gen + 1u) * nloc) {
            __builtin_amdgcn_fence(__ATOMIC_RELEASE, "agent");
            asm volatile("s_waitcnt vmcnt(0)" ::: "memory");
            const unsigned og = xb_add(&bar[XB_TOP], 1u);
            const unsigned tg = og / nx;
            if (og + 1u == (tg + 1u) * nx) xb_add(&bar[XB_TOPGEN], 1u);
            else XB_SPIN(xb_ld(&bar[XB_TOPGEN]) == tg, bar);
            __builtin_amdgcn_fence(__ATOMIC_ACQUIRE, "agent");
            xb_add(&bar[XB_XGEN(b.x)], 1u);
            asm volatile("s_waitcnt vmcnt(0)" ::: "memory");
        } else {
            XB_SPIN(xb_ld(&bar[XB_XGEN(b.x)]) == gen, bar);
            __builtin_amdgcn_fence(__ATOMIC_ACQUIRE, "agent");
            asm volatile("s_waitcnt vmcnt(0)" ::: "memory");
        }
    }
    __syncthreads();
}

namespace pg8 {
#define PG8_LAS __attribute__((address_space(3)))
typedef unsigned short bf16_t;
typedef short bf16x8 __attribute__((ext_vector_type(8)));
typedef float f32x4 __attribute__((ext_vector_type(4)));
typedef unsigned u32x4 __attribute__((ext_vector_type(4)));
constexpr int BM = 256, BK = 64, HALF = 128, HTB = HALF * BK * 2  , STAGE_BYTES = 8 * HTB, NXCD = 8, WGM = 8;

__host__ __device__ __forceinline__ int lds_byte(int r, int c) { const int st = (r >> 4) * 2 + (c >> 5), rr = r & 15, cc = c & 31, ob = rr * 64 + cc * 2; return st * 1024 + (ob ^ (((ob >> 9) & 1) << 5)); }
__host__ __device__ __forceinline__ void stage_rc(int b, int& R, int& C) { const int st = b / 1024, sb = b % 1024, swz = sb ^ (((sb >> 9) & 1) << 5); R = (st >> 1) * 16 + swz / 64; C = (st & 1) * 32 + (swz % 64) / 2; }
__host__ __device__ __forceinline__ int perm32(int rho) { const int n = rho >> 4, i = rho & 15; return 8 * (i >> 2) + 4 * n + (i & 3); }

struct Unit { int pm, pn; };
struct Gemm { const bf16_t* A; const bf16_t* Bt; int M, N, K; };

struct StaticOrder {
    int nM, nN, nwg, G, c;
    __host__ __device__ void init(int M, int N, int G_, int c_) { nM = M / BM; nN = N / BM; nwg = nM * nN; G = G_; c = c_; }
    __host__ __device__ bool next(int i, Unit& u) const {
        const long L = (long)i * G + c; if (L >= nwg) return false;
        int wgid = (int)L; { const int q = nwg / NXCD, r = nwg % NXCD, xcd = wgid % NXCD, off = wgid / NXCD; wgid = (xcd < r ? xcd * (q + 1) : r * (q + 1) + (xcd - r) * q) + off; }
        const int nig = WGM * nN, gid = wgid / nig, fm = gid * WGM, gsz = (nM - fm) < WGM ? (nM - fm) : WGM;
        u.pm = fm + ((wgid % nig) % gsz); u.pn = (wgid % nig) / gsz; return true;
    }
    __device__ __forceinline__ void a_ready(const Unit&) const {}
    __device__ __forceinline__ void done(const Unit&) const {}
};
__device__ __forceinline__ unsigned cvt_pk_bf16(float lo, float hi) { unsigned r; asm volatile("v_cvt_pk_bf16_f32 %0, %1, %2" : "=v"(r) : "v"(lo), "v"(hi)); return r; }
template <class Epi, class Sched, bool STAMP = false>
__device__ __forceinline__ void gemm_phase(PG8_LAS unsigned char* lds, const Gemm g, const Sched& S, const Epi& E, unsigned long long* stamps) {
    const int tid = threadIdx.x, wid = __builtin_amdgcn_readfirstlane(tid >> 6), lane = tid & 63, wr = wid >> 2, wc = wid & 3, fr = lane & 15, fq = lane >> 4;
    const int K = g.K, nt = K / BK;
    int ts_lo = 0, ts_hi = 0, nts = 0; const unsigned long long rt_entry = STAMP ? (unsigned long long)wall_clock64() : 0ull;
#define PG8_STAMP() do { if (STAMP && wid == 0 && nts < 64) { const unsigned long long _c = (unsigned long long)clock64(); \
        ts_lo = (lane == nts) ? (int)(unsigned)_c : ts_lo; ts_hi = (lane == nts) ? (int)(unsigned)(_c >> 32) : ts_hi; ++nts; } } while (0)
    PG8_STAMP();
    unsigned voffA[2], voffB[2];
#pragma unroll
    for (int i = 0; i < 2; ++i) { int R, C; stage_rc(tid * 16 + i * 8192, R, C); const int Rb = Epi::PERM ? ((R & ~31) + perm32(R & 31)) : R;
        voffA[i] = (unsigned)(R * K + C) * 2u; voffB[i] = (unsigned)(Rb * K + C) * 2u; }
    const size_t kstep = (size_t)(BK * 2);
    const size_t hstep = (size_t)HALF * K * 2;
    const size_t tstep = 2 * hstep;
    const unsigned ldsw = (unsigned)wid * 1024u;
    const int aoff = lds_byte(wr * 64 + fr, fq * 8), boff = lds_byte(wc * 32 + fr, fq * 8);
#define PG8_SA(b, h) (((b) * 2 + (h)) * HTB)
#define PG8_SB(b, h) ((4 + (b) * 2 + (h)) * HTB)
#define PG8_STAGE(bufoff, gbase, voff) do { _Pragma("unroll") for (int _i = 0; _i < 2; ++_i) \
        __builtin_amdgcn_global_load_lds((const unsigned*)((const char*)(gbase) + (voff)[_i]), (PG8_LAS unsigned*)(lds + (bufoff) + ldsw + _i * 8192), 16, 0, 0); } while (0)
#define PG8_LDA(dst, b, h) do { _Pragma("unroll") for (int m = 0; m < 4; ++m) _Pragma("unroll") for (int k = 0; k < 2; ++k) dst[m][k] = *(const PG8_LAS bf16x8*)(lds + PG8_SA(b, h) + aoff + m * 2048 + k * 1024); } while (0)
#define PG8_LDB(dst, b, h) do { _Pragma("unroll") for (int n = 0; n < 2; ++n) _Pragma("unroll") for (int k = 0; k < 2; ++k) dst[n][k] = *(const PG8_LAS bf16x8*)(lds + PG8_SB(b, h) + boff + n * 2048 + k * 1024); } while (0)
#define PG8_MMA(ai, bj, At, Bt) do { __builtin_amdgcn_s_setprio(1); _Pragma("unroll") for (int m = 0; m < 4; ++m) _Pragma("unroll") for (int n = 0; n < 2; ++n) _Pragma("unroll") for (int k = 0; k < 2; ++k) \
        acc[ai][bj][m][n] = __builtin_amdgcn_mfma_f32_16x16x32_bf16(Bt[n][k], At[m][k], acc[ai][bj][m][n], 0, 0, 0); __builtin_amdgcn_s_setprio(0); } while (0)
#define PG8_WAIT_V(n) asm volatile("s_waitcnt vmcnt(" #n ")" ::: "memory")
#define PG8_WAIT_L(n) asm volatile("s_waitcnt lgkmcnt(" #n ")" ::: "memory")
#define PG8_BAR __builtin_amdgcn_s_barrier()
#define PG8_SCHED __builtin_amdgcn_sched_barrier(0)
    Unit cur, nxt; int ui = 0;
    if (!S.next(0, cur)) return;
    f32x4 acc[2][2][4][2];
#pragma unroll
    for (int a = 0; a < 2; ++a)
#pragma unroll
        for (int b = 0; b < 2; ++b)
#pragma unroll
            for (int m = 0; m < 4; ++m)
#pragma unroll
                for (int n = 0; n < 2; ++n) acc[a][b][m][n] = (f32x4){0.f, 0.f, 0.f, 0.f};
    bf16x8 At[4][2], B0[2][2], B1[2][2];
    const char* cA = (const char*)g.A + (size_t)cur.pm * tstep; const char* cB = (const char*)g.Bt + (size_t)cur.pn * tstep;
    S.a_ready(cur);
    PG8_STAGE(PG8_SB(0, 0), cB, voffB); PG8_STAGE(PG8_SA(0, 0), cA, voffA); PG8_STAGE(PG8_SB(0, 1), cB + hstep, voffB); PG8_STAGE(PG8_SA(0, 1), cA + hstep, voffA);
    if (wr == 1) PG8_BAR;
    PG8_WAIT_V(4); PG8_BAR;
    PG8_STAGE(PG8_SB(1, 0), cB + kstep, voffB); PG8_STAGE(PG8_SA(1, 0), cA + kstep, voffA); PG8_STAGE(PG8_SB(1, 1), cB + hstep + kstep, voffB);
    PG8_WAIT_V(6); PG8_BAR;
    PG8_STAMP();
    for (;;) {
        const bool has_next = S.next(ui + 1, nxt);
        const char* nA = has_next ? (const char*)g.A + (size_t)nxt.pm * tstep : cA; const char* nB = has_next ? (const char*)g.Bt + (size_t)nxt.pn * tstep : cB;
        for (int t = 0; t < nt; t += 2) {
            const bool last = (t == nt - 2);
            const char* a1 = cA + (size_t)(t + 1) * kstep;
            const char* a2 = last ? nA : cA + (size_t)(t + 2) * kstep; const char* b2 = last ? nB : cB + (size_t)(t + 2) * kstep;
            const char* a3 = a2 + kstep; const char* b3 = b2 + kstep;
            if (last && has_next) S.a_ready(nxt);
            PG8_LDB(B0, 0, 0); PG8_SCHED; PG8_LDA(At, 0, 0); PG8_STAGE(PG8_SA(1, 1), a1 + hstep, voffA);
            PG8_WAIT_L(8); PG8_BAR; PG8_WAIT_L(0); PG8_MMA(0, 0, At, B0); PG8_BAR; PG8_SCHED;
            PG8_LDB(B1, 0, 1); PG8_STAGE(PG8_SB(0, 0), b2, voffB);
            PG8_BAR; PG8_WAIT_L(0); PG8_MMA(0, 1, At, B1); PG8_BAR;
            PG8_LDA(At, 0, 1); PG8_STAGE(PG8_SA(0, 0), a2, voffA);
            PG8_BAR; PG8_WAIT_L(0); PG8_MMA(1, 0, At, B0); PG8_BAR; PG8_SCHED;
            PG8_STAGE(PG8_SB(0, 1), b2 + hstep, voffB);
            PG8_WAIT_V(6); PG8_BAR; PG8_MMA(1, 1, At, B1); PG8_BAR;
            PG8_LDB(B0, 1, 0); PG8_SCHED; PG8_LDA(At, 1, 0); PG8_STAGE(PG8_SA(0, 1), a2 + hstep, voffA);
            PG8_WAIT_L(8); PG8_BAR; PG8_WAIT_L(0); PG8_MMA(0, 0, At, B0); PG8_BAR; PG8_SCHED;
            PG8_LDB(B1, 1, 1); PG8_STAGE(PG8_SB(1, 0), b3, voffB);
            PG8_BAR; PG8_WAIT_L(0); PG8_MMA(0, 1, At, B1); PG8_BAR;
            PG8_LDA(At, 1, 1); PG8_STAGE(PG8_SA(1, 0), a3, voffA);
            PG8_BAR; PG8_WAIT_L(0); PG8_MMA(1, 0, At, B0); PG8_BAR; PG8_SCHED;
            PG8_STAGE(PG8_SB(1, 1), b3 + hstep, voffB);
            PG8_WAIT_V(6); PG8_BAR; PG8_MMA(1, 1, At, B1); PG8_BAR;
        }
        PG8_STAMP();
        if constexpr (!Epi::AFTER_DRAIN) { E(acc, cur, wr, wc, fr, fq); S.done(cur); }
        PG8_STAMP();
        if (!has_next) break;
#pragma unroll
        for (int a = 0; a < 2; ++a)
#pragma unroll
            for (int b = 0; b < 2; ++b)
#pragma unroll
                for (int m = 0; m < 4; ++m)
#pragma unroll
                    for (int n = 0; n < 2; ++n) acc[a][b][m][n] = (f32x4){0.f, 0.f, 0.f, 0.f};
        cur = nxt; cA = nA; cB = nB; ++ui;
    }
    PG8_WAIT_V(0);
    if (wr == 0) PG8_BAR;
    PG8_BAR;
    if constexpr (Epi::AFTER_DRAIN) { E.fused(acc, cur, wr, wc, fr, fq, lds, wid, lane); S.done(cur); }
    PG8_STAMP();
    if (STAMP && wid == 0) { stamps[lane] = lane < nts ? (((unsigned long long)(unsigned)ts_hi << 32) | (unsigned)ts_lo) : 0ull;
        if (lane == 62) stamps[62] = rt_entry; if (lane == 63) stamps[63] = (unsigned long long)wall_clock64(); }
#undef PG8_STAMP
#undef PG8_SA
#undef PG8_SB
#undef PG8_STAGE
#undef PG8_LDA
#undef PG8_LDB
#undef PG8_MMA
#undef PG8_WAIT_V
#undef PG8_WAIT_L
#undef PG8_BAR
#undef PG8_SCHED
}
}

using pg8::Unit;
struct EpiF32 {
    static constexpr bool PERM = false, AFTER_DRAIN = false;
    float* C; int ldc;
    __device__ __forceinline__ void operator()(const f32x4 (&acc)[2][2][4][2], const Unit& u, int wr, int wc, int fr, int fq) const {
        const int row0 = u.pm * 256 + wr * 64 + fr, col0 = u.pn * 256 + wc * 32 + 4 * fq;
#pragma unroll
        for (int ai = 0; ai < 2; ++ai)
#pragma unroll
            for (int m = 0; m < 4; ++m) { float* rowp = C + (size_t)(row0 + ai * 128 + m * 16) * ldc + col0;
#pragma unroll
                for (int bj = 0; bj < 2; ++bj)
#pragma unroll
                    for (int n = 0; n < 2; ++n) *(f32x4*)(rowp + bj * 128 + n * 16) = acc[ai][bj][m][n]; }
    }
};
struct EpiBf16P {
    static constexpr bool PERM = true, AFTER_DRAIN = false;
    bf16_t* O; int ldc;
    __device__ __forceinline__ void operator()(const f32x4 (&acc)[2][2][4][2], const Unit& u, int wr, int wc, int fr, int fq) const {
        const int row0 = u.pm * 256 + wr * 64 + fr, col0 = u.pn * 256 + wc * 32 + 8 * fq;
#pragma unroll
        for (int ai = 0; ai < 2; ++ai)
#pragma unroll
            for (int m = 0; m < 4; ++m) { bf16_t* rowp = O + (size_t)(row0 + ai * 128 + m * 16) * ldc + col0;
#pragma unroll
                for (int bj = 0; bj < 2; ++bj) { const f32x4 v0 = acc[ai][bj][m][0], v1 = acc[ai][bj][m][1];
                    u32x4 w; w.x = pk2(v0[0], v0[1]); w.y = pk2(v0[2], v0[3]); w.z = pk2(v1[0], v1[1]); w.w = pk2(v1[2], v1[3]);
                    *(u32x4*)(rowp + bj * 128) = w; } }
    }
};
struct EpiSwiGLU {
    static constexpr bool PERM = true, AFTER_DRAIN = false;
    bf16_t* FF;
    __device__ __forceinline__ void operator()(const f32x4 (&acc)[2][2][4][2], const Unit& u, int wr, int wc, int fr, int fq) const {
        const int row0 = u.pm * 256 + wr * 64 + fr, col0 = u.pn * 128 + wc * 32 + 8 * fq;
#pragma unroll
        for (int ai = 0; ai < 2; ++ai)
#pragma unroll
            for (int m = 0; m < 4; ++m) {
                const f32x4 g0 = acc[ai][0][m][0], g1 = acc[ai][0][m][1], u0 = acc[ai][1][m][0], u1 = acc[ai][1][m][1];
                u32x4 w;
                w.x = pk2(siluf_(g0[0]) * u0[0], siluf_(g0[1]) * u0[1]); w.y = pk2(siluf_(g0[2]) * u0[2], siluf_(g0[3]) * u0[3]);
                w.z = pk2(siluf_(g1[0]) * u1[0], siluf_(g1[1]) * u1[1]); w.w = pk2(siluf_(g1[2]) * u1[2], siluf_(g1[3]) * u1[3]);
                *(u32x4*)(FF + (size_t)(row0 + ai * 128 + m * 16) * DFF + col0) = w; }
    }
};
struct RotOrder : pg8::StaticOrder {
    __device__ __forceinline__ bool next(int i, Unit& u) const { if (!pg8::StaticOrder::next(i, u)) return false; u.pn = u.pn + 12; if (u.pn >= 28) u.pn -= 28; return true; }
};
struct EpiIn {
    static constexpr bool PERM = true, AFTER_DRAIN = false;
    bf16_t* QC; bf16_t* KC; bf16_t* VT; bf16_t* HG; float* outk; float* outv; float qscale;
    __device__ __forceinline__ void operator()(const f32x4 (&acc)[2][2][4][2], const Unit& u, int wr, int wc, int fr, int fq) const {
        const int region = u.pn >> 2;
        if (region == 2) {
#pragma unroll
            for (int ai = 0; ai < 2; ++ai)
#pragma unroll
                for (int bj = 0; bj < 2; ++bj) {
                    const int h = (u.pn & 3) * 2 + bj, d = wc * 32 + 8 * fq;
                    bf16_t* vb = VT + (((size_t)(h * 16 + fr) * 64 + u.pm) * 128 + d) * 16 + ai * 8 + wr * 4;
#pragma unroll
                    for (int n = 0; n < 2; ++n)
#pragma unroll
                        for (int j = 0; j < 4; ++j) { u32x2 w; w.x = pk2(acc[ai][bj][0][n][j], acc[ai][bj][1][n][j]); w.y = pk2(acc[ai][bj][2][n][j], acc[ai][bj][3][n][j]);
                            *(u32x2*)(vb + (4 * n + j) * 16) = w; }
#pragma unroll
                    for (int m = 0; m < 4; ++m) { const int t = u.pm * 256 + ai * 128 + wr * 64 + m * 16 + fr;
                        if (t >= T_ - 2048) { float* o = outv + (size_t)(t - (T_ - 2048)) * 1024 + h * 128 + d; *(f32x4*)o = acc[ai][bj][m][0]; *(f32x4*)(o + 4) = acc[ai][bj][m][1]; } }
                }
            return;
        }
#pragma unroll
        for (int ai = 0; ai < 2; ++ai)
#pragma unroll
            for (int m = 0; m < 4; ++m) {
                const int t = u.pm * 256 + ai * 128 + wr * 64 + m * 16 + fr;
#pragma unroll
                for (int bj = 0; bj < 2; ++bj) {
                    f32x4 v0 = acc[ai][bj][m][0], v1 = acc[ai][bj][m][1];
                    if (region >= 3) {
                        u32x4 w; w.x = pk2(v0[0], v0[1]); w.y = pk2(v0[2], v0[3]); w.z = pk2(v1[0], v1[1]); w.w = pk2(v1[2], v1[3]);
                        *(u32x4*)(HG + (size_t)t * 4096 + (u.pn - 12) * 256 + bj * 128 + wc * 32 + 8 * fq) = w;
                    } else {
                        const int h = (u.pn & 3) * 2 + bj, d = wc * 32 + 8 * fq, rho = t & 15, uu = t >> 4;
                        if (region == 0) {
                            v0 = v0 * qscale; v1 = v1 * qscale;
                            u32x4 w; w.x = pk2(v0[0], v0[1]); w.y = pk2(v0[2], v0[3]); w.z = pk2(v1[0], v1[1]); w.w = pk2(v1[2], v1[3]);
                            *(u32x4*)(QC + ((size_t)(h * 16 + rho) * 1024 + uu) * 128 + d) = w;
                        } else if (region == 1) {
                            u32x4 w; w.x = pk2(v0[0], v0[1]); w.y = pk2(v0[2], v0[3]); w.z = pk2(v1[0], v1[1]); w.w = pk2(v1[2], v1[3]);
                            *(u32x4*)(KC + ((((size_t)(h * 16 + rho) * 64 + (uu >> 4)) * 4 + wc) * 16 + (uu & 15)) * 32 + 8 * fq) = w;
                            if (t >= T_ - 2048) { float* o = outk + (size_t)(t - (T_ - 2048)) * 1024 + h * 128 + d; *(f32x4*)o = v0; *(f32x4*)(o + 4) = v1; }
                        } else {
                            bf16_t* vb = VT + (((size_t)(h * 16 + rho) * 64 + (uu >> 4)) * 128 + d) * 16 + (uu & 15);
#pragma unroll
                            for (int j = 0; j < 4; ++j) { vb[j * 16] = f2bf(v0[j]); vb[(4 + j) * 16] = f2bf(v1[j]); }
                            if (t >= T_ - 2048) { float* o = outv + (size_t)(t - (T_ - 2048)) * 1024 + h * 128 + d; *(f32x4*)o = v0; *(f32x4*)(o + 4) = v1; }
                        }
                    }
                }
            }
    }
};

#define WS_PTR(type, off) ((type*)(P.ws + (off)))
#define LDS_WAIT() asm volatile("s_waitcnt lgkmcnt(0)" ::: "memory")
#if MK_SETTLE
#define SETTLE() do { __builtin_amdgcn_sched_barrier(0); asm volatile("s_nop 15\n\ts_nop 15"); __builtin_amdgcn_sched_barrier(0); } while (0)
#else
#define SETTLE() do {} while (0)
#endif

__device__ __forceinline__ void transpose_item(const float* W, int K, int N, bf16_t* WT, int grp, int gstride, int goff, float* scr, int item, int lane) {
    const int nblk = N / 32, kb = item / nblk, nb = item % nblk, k0 = 64 * kb, n0 = 32 * nb;
    const int rowbase = (n0 / grp) * gstride + (n0 % grp) + goff;
    float wv[32];
#pragma unroll
    for (int i = 0; i < 32; ++i) wv[i] = __builtin_nontemporal_load(W + (size_t)(k0 + 2 * i + (lane >> 5)) * N + n0 + (lane & 31));
#pragma unroll
    for (int i = 0; i < 32; ++i) scr[(2 * i + (lane >> 5)) * 33 + (lane & 31)] = wv[i];
    LDS_WAIT();
    const int c = lane & 7;
#pragma unroll
    for (int j = 0; j < 4; ++j) { const int n = (lane >> 3) + 8 * j; const float* s = scr + (8 * c) * 33 + n;
        u32x4 o; o.x = pk2(s[0 * 33], s[1 * 33]); o.y = pk2(s[2 * 33], s[3 * 33]); o.z = pk2(s[4 * 33], s[5 * 33]); o.w = pk2(s[6 * 33], s[7 * 33]);
        *(u32x4*)(WT + (size_t)(rowbase + n) * K + k0 + 8 * c) = o; }
    LDS_WAIT();
}
__device__ __forceinline__ void rms_row_bf16(const float* x, const float* g, bf16_t* o, int lane) {
    f32x4 v[8]; float ss = 0.f;
#pragma unroll
    for (int j = 0; j < 8; ++j) { v[j] = ((const f32x4*)x)[lane + 64 * j]; ss += v[j][0] * v[j][0] + v[j][1] * v[j][1] + v[j][2] * v[j][2] + v[j][3] * v[j][3]; }
    const float r = rsqrtf(wave_sum(ss) * (1.f / 2048.f) + EPS_);
#pragma unroll
    for (int j = 0; j < 8; ++j) { const f32x4 gv = ((const f32x4*)g)[lane + 64 * j];
        u32x2 w; w.x = pk2(v[j][0] * r * gv[0], v[j][1] * r * gv[1]); w.y = pk2(v[j][2] * r * gv[2], v[j][3] * r * gv[3]);
        ((u32x2*)o)[lane + 64 * j] = w; }
}
__device__ __forceinline__ f32x4 ld4(const float* p, int i) { return ((const f32x4*)p)[i]; }
__device__ __forceinline__ f32x4 ld4(const bf16_t* p, int i) { const u32x2 w = ((const u32x2*)p)[i]; return (f32x4){bflo(w.x), bfhi(w.x), bflo(w.y), bfhi(w.y)}; }
__device__ __forceinline__ f32x4 ld4nt(const float* p, int i) { return __builtin_nontemporal_load((const f32x4*)p + i); }
__device__ __forceinline__ f32x4 ld4nt(const bf16_t* p, int i) { const u32x2 w = __builtin_nontemporal_load((const u32x2*)p + i); return (f32x4){bflo(w.x), bfhi(w.x), bflo(w.y), bfhi(w.y)}; }
__device__ __forceinline__ void st4nt(float* p, int i, f32x4 v) { __builtin_nontemporal_store(v, (f32x4*)p + i); }
__device__ __forceinline__ void st4(float* p, int i, f32x4 v) { ((f32x4*)p)[i] = v; }
__device__ __forceinline__ void st4(bf16_t* p, int i, f32x4 v) { u32x2 w; w.x = pk2(v[0], v[1]); w.y = pk2(v[2], v[3]); ((u32x2*)p)[i] = w; }
template <class TM, class TX> __device__ __forceinline__ void post_mix_row(const float* x, const TM* mix, const float* g1, const float* g2, TX* x1out, bf16_t* h2, int lane) {
    f32x4 v[8]; float ss = 0.f;
#pragma unroll
    for (int j = 0; j < 8; ++j) { v[j] = ld4(mix, lane + 64 * j); ss += v[j][0] * v[j][0] + v[j][1] * v[j][1] + v[j][2] * v[j][2] + v[j][3] * v[j][3]; }
    const float r = rsqrtf(wave_sum(ss) * (1.f / 2048.f) + EPS_);
    float ss2 = 0.f;
#pragma unroll
    for (int j = 0; j < 8; ++j) { const f32x4 gv = ((const f32x4*)g1)[lane + 64 * j]; const f32x4 xv = ((const f32x4*)x)[lane + 64 * j];
        v[j] = xv + v[j] * r * gv; st4(x1out, lane + 64 * j, v[j]);
        ss2 += v[j][0] * v[j][0] + v[j][1] * v[j][1] + v[j][2] * v[j][2] + v[j][3] * v[j][3]; }
    const float r2 = rsqrtf(wave_sum(ss2) * (1.f / 2048.f) + EPS_);
#pragma unroll
    for (int j = 0; j < 8; ++j) { const f32x4 gv = ((const f32x4*)g2)[lane + 64 * j];
        u32x2 w; w.x = pk2(v[j][0] * r2 * gv[0], v[j][1] * r2 * gv[1]); w.y = pk2(v[j][2] * r2 * gv[2], v[j][3] * r2 * gv[3]);
        ((u32x2*)h2)[lane + 64 * j] = w; }
}
template <class TM, class TX> __device__ __forceinline__ void final_row(const TX* x1, const TM* ffo, const float* g, float* y, int lane) {
    f32x4 v[8]; float ss = 0.f;
#pragma unroll
    for (int j = 0; j < 8; ++j) { v[j] = ld4(ffo, lane + 64 * j); ss += v[j][0] * v[j][0] + v[j][1] * v[j][1] + v[j][2] * v[j][2] + v[j][3] * v[j][3]; }
    const float r = rsqrtf(wave_sum(ss) * (1.f / 2048.f) + EPS_);
#pragma unroll
    for (int j = 0; j < 8; ++j) { const f32x4 gv = ((const f32x4*)g)[lane + 64 * j]; const f32x4 xv = ld4(x1, lane + 64 * j);
        ((f32x4*)y)[lane + 64 * j] = xv + v[j] * r * gv; }
}

__device__ __forceinline__ float sq4(f32x4 v) { return v[0] * v[0] + v[1] * v[1] + v[2] * v[2] + v[3] * v[3]; }
__device__ __forceinline__ void rms_row2_bf16(const float* x, const float* g, bf16_t* o, size_t d2, int lane) {
    f32x4 v[2][8]; float ss[2] = {0.f, 0.f};
#pragma unroll
    for (int rr = 0; rr < 2; ++rr)
#pragma unroll
        for (int j = 0; j < 8; ++j) v[rr][j] = ld4nt(x + rr * d2, lane + 64 * j);
#pragma unroll
    for (int rr = 0; rr < 2; ++rr)
#pragma unroll
        for (int j = 0; j < 8; ++j) ss[rr] += sq4(v[rr][j]);
    const float r0 = rsqrtf(wave_sum(ss[0]) * (1.f / 2048.f) + EPS_), r1 = rsqrtf(wave_sum(ss[1]) * (1.f / 2048.f) + EPS_);
#pragma unroll
    for (int j = 0; j < 8; ++j) { const f32x4 gv = ((const f32x4*)g)[lane + 64 * j];
        st4(o, lane + 64 * j, v[0][j] * r0 * gv); st4(o + d2, lane + 64 * j, v[1][j] * r1 * gv); }
}
template <class TM, class TX> __device__ __forceinline__ void post_mix_row2(const float* x, const TM* mix, const float* g1, const float* g2, TX* x1out, bf16_t* h2, size_t d2, int lane) {
    f32x4 v[2][8], xv[2][8]; float ss[2] = {0.f, 0.f};
#pragma unroll
    for (int rr = 0; rr < 2; ++rr)
#pragma unroll
        for (int j = 0; j < 8; ++j) { v[rr][j] = ld4nt(mix + rr * d2, lane + 64 * j); xv[rr][j] = ld4nt(x + rr * d2, lane + 64 * j); }
#pragma unroll
    for (int rr = 0; rr < 2; ++rr)
#pragma unroll
        for (int j = 0; j < 8; ++j) ss[rr] += sq4(v[rr][j]);
    const float r0 = rsqrtf(wave_sum(ss[0]) * (1.f / 2048.f) + EPS_), r1 = rsqrtf(wave_sum(ss[1]) * (1.f / 2048.f) + EPS_);
    float s2[2] = {0.f, 0.f};
#pragma unroll
    for (int j = 0; j < 8; ++j) { const f32x4 gv = ((const f32x4*)g1)[lane + 64 * j];
        v[0][j] = xv[0][j] + v[0][j] * r0 * gv; v[1][j] = xv[1][j] + v[1][j] * r1 * gv;
        st4(x1out, lane + 64 * j, v[0][j]); st4(x1out + d2, lane + 64 * j, v[1][j]);
        s2[0] += sq4(v[0][j]); s2[1] += sq4(v[1][j]); }
    const float q0 = rsqrtf(wave_sum(s2[0]) * (1.f / 2048.f) + EPS_), q1 = rsqrtf(wave_sum(s2[1]) * (1.f / 2048.f) + EPS_);
#pragma unroll
    for (int j = 0; j < 8; ++j) { const f32x4 gv = ((const f32x4*)g2)[lane + 64 * j];
        st4(h2, lane + 64 * j, v[0][j] * q0 * gv); st4(h2 + d2, lane + 64 * j, v[1][j] * q1 * gv); }
}
template <class TM, class TX> __device__ __forceinline__ void final_row2(const TX* x1, const TM* ffo, const float* g, float* y, size_t d2, int lane) {
    f32x4 v[2][8], xv[2][8]; float ss[2] = {0.f, 0.f};
#pragma unroll
    for (int rr = 0; rr < 2; ++rr)
#pragma unroll
        for (int j = 0; j < 8; ++j) { v[rr][j] = ld4nt(ffo + rr * d2, lane + 64 * j); xv[rr][j] = ld4nt(x1 + rr * d2, lane + 64 * j); }
#pragma unroll
    for (int rr = 0; rr < 2; ++rr)
#pragma unroll
        for (int j = 0; j < 8; ++j) ss[rr] += sq4(v[rr][j]);
    const float r0 = rsqrtf(wave_sum(ss[0]) * (1.f / 2048.f) + EPS_), r1 = rsqrtf(wave_sum(ss[1]) * (1.f / 2048.f) + EPS_);
#pragma unroll
    for (int j = 0; j < 8; ++j) { const f32x4 gv = ((const f32x4*)g)[lane + 64 * j];
        st4nt(y, lane + 64 * j, xv[0][j] + v[0][j] * r0 * gv); st4nt(y + d2, lane + 64 * j, xv[1][j] + v[1][j] * r1 * gv); }
}

template <class F> __device__ __forceinline__ void skinny_gemm(const bf16_t* A, const bf16_t* Bt, int K, int N, float* red, F store, int i0 = -1, int istep = 0) {
    const int tid = threadIdx.x, wave = tid >> 6, lane = tid & 63, r16 = lane & 15, g = lane >> 4;
    if (i0 < 0) { i0 = blockIdx.x; istep = gridDim.x; }
    for (int item = i0; item < N / 16; item += istep) {
        const int n0 = item * 16, kper = K >> 3, kb = wave * kper;
        const bf16_t* a0p = A + (size_t)r16 * K + kb + g * 8; const bf16_t* a1p = a0p + (size_t)16 * K;
        const bf16_t* bp = Bt + (size_t)(n0 + r16) * K + kb + g * 8;
        f32x4 c0 = {0.f, 0.f, 0.f, 0.f}, c1 = {0.f, 0.f, 0.f, 0.f};
#pragma unroll 8
        for (int k = 0; k < kper; k += 32) {
            const s16x8 a0 = *(const s16x8*)(a0p + k), a1 = *(const s16x8*)(a1p + k), b = *(const s16x8*)(bp + k);
            c0 = __builtin_amdgcn_mfma_f32_16x16x32_bf16(a0, b, c0, 0, 0, 0); c1 = __builtin_amdgcn_mfma_f32_16x16x32_bf16(a1, b, c1, 0, 0, 0);
            asm volatile("" : "+v"(c0), "+v"(c1) : "v"(a0), "v"(a1), "v"(b)); }
#pragma unroll
        for (int j = 0; j < 4; ++j) { red[wave * 512 + (g * 4 + j) * 16 + r16] = c0[j]; red[wave * 512 + (16 + g * 4 + j) * 16 + r16] = c1[j]; }
        __syncthreads();
        float s = 0.f;
#pragma unroll
        for (int w = 0; w < 8; ++w) s += red[w * 512 + tid];
        store(tid >> 4, n0 + (tid & 15), s);
        __syncthreads();
    }
}
__device__ __forceinline__ void skinny_gu(const bf16_t* A, const bf16_t* Bt, bf16_t* ffs, float* red) {
    const int tid = threadIdx.x, wave = tid >> 6, lane = tid & 63, r16 = lane & 15, g = lane >> 4;
    constexpr int K = 2048;
    for (int item = blockIdx.x; item < DFF / 16; item += gridDim.x) {
        const int n0 = item * 16, kper = K >> 3, kb = wave * kper;
        const int rowg = (n0 / 128) * 256 + (n0 % 128) + r16;
        const bf16_t* a0p = A + (size_t)r16 * K + kb + g * 8; const bf16_t* a1p = a0p + (size_t)16 * K;
        const bf16_t* bgp = Bt + (size_t)rowg * K + kb + g * 8; const bf16_t* bup = bgp + (size_t)128 * K;
        f32x4 c0 = {0.f, 0.f, 0.f, 0.f}, c1 = c0, c2 = c0, c3 = c0;
#pragma unroll 8
        for (int k = 0; k < kper; k += 32) {
            const s16x8 a0 = *(const s16x8*)(a0p + k), a1 = *(const s16x8*)(a1p + k), bg = *(const s16x8*)(bgp + k), bu = *(const s16x8*)(bup + k);
            c0 = __builtin_amdgcn_mfma_f32_16x16x32_bf16(a0, bg, c0, 0, 0, 0); c1 = __builtin_amdgcn_mfma_f32_16x16x32_bf16(a1, bg, c1, 0, 0, 0);
            c2 = __builtin_amdgcn_mfma_f32_16x16x32_bf16(a0, bu, c2, 0, 0, 0); c3 = __builtin_amdgcn_mfma_f32_16x16x32_bf16(a1, bu, c3, 0, 0, 0);
            asm volatile("" : "+v"(c0), "+v"(c1), "+v"(c2), "+v"(c3) : "v"(a0), "v"(a1), "v"(bg), "v"(bu)); }
#pragma unroll
        for (int j = 0; j < 4; ++j) { red[wave * 1024 + (g * 4 + j) * 16 + r16] = c0[j]; red[wave * 1024 + (16 + g * 4 + j) * 16 + r16] = c1[j];
            red[wave * 1024 + 512 + (g * 4 + j) * 16 + r16] = c2[j]; red[wave * 1024 + 512 + (16 + g * 4 + j) * 16 + r16] = c3[j]; }
        __syncthreads();
        float sg = 0.f, su = 0.f;
#pragma unroll
        for (int w = 0; w < 8; ++w) { sg += red[w * 1024 + tid]; su += red[w * 1024 + 512 + tid]; }
        ffs[(size_t)(tid >> 4) * DFF + n0 + (tid & 15)] = f2bf(siluf_(sg) * su);
        __syncthreads();
    }
}

__device__ __forceinline__ int att_tile0(int r, int rho, int q0) {
    const int delta = r - rho;
    const int hmax = (delta == 0) ? 128 : (((delta & 3) == 0) ? ((512 - delta) >> 4) : ((128 - delta) >> 4));
    const int t0 = (q0 - hmax) >> 4; return t0 < 0 ? 0 : t0;
}
__device__ __forceinline__ void attn_item(const Params& P, int item_, int lane) {
    const int item = __builtin_amdgcn_readfirstlane(item_);
    const int r = item & 15, pm = (item >> 4) & 63, h = item >> 10;
    const int q0 = pm * 16, g = lane >> 4, r16 = lane & 15;
    const bf16_t* QC = WS_PTR(const bf16_t, WS_QC);
    const char* KCu = (const char*)(WS_PTR(const bf16_t, WS_KC) + (size_t)h * 16 * 1024 * 128);
    const char* VTu = (const char*)(WS_PTR(const bf16_t, WS_VT) + (size_t)h * 16 * 128 * 1024);
    const unsigned klane = (unsigned)(r16 * 64 + g * 16), vlane = (unsigned)(r16 * 32 + g * 8);
    s16x8 qf[4];
    { const bf16_t* qb = QC + ((size_t)(h * 16 + r) * 1024 + q0 + r16) * 128 + g * 8;
#pragma unroll
      for (int kk = 0; kk < 4; ++kk) qf[kk] = *(const s16x8*)(qb + 32 * kk); }
    float m_run = -INFINITY, l_run = 0.f;
    f32x4 o[8];
#pragma unroll
    for (int dt = 0; dt < 8; ++dt) o[dt] = (f32x4){0.f, 0.f, 0.f, 0.f};
    int NT = 0;
    for (int rho = 0; rho < 16; ++rho) NT += pm - att_tile0(r, rho, q0) + 1;
#define ATT_LOAD(KF, VF, rho_, tile_) do { \
        const char* kp_ = KCu + (size_t)(((rho_) * 64 + (tile_)) * 4096) + klane; \
        _Pragma("unroll") for (int kk = 0; kk < 4; ++kk) KF[kk] = *(const s16x8*)(kp_ + 1024 * kk); \
        const char* vp_ = VTu + (size_t)(((rho_) * 64 + (tile_)) * 4096) + vlane; \
        _Pragma("unroll") for (int dt = 0; dt < 8; ++dt) VF[dt] = *(const s16x4*)(vp_ + 512 * dt); } while (0)
#define ATT_NEXT(rho_, tile_) do { if (++tile_ > pm) { if (rho_ < 15) { ++rho_; tile_ = att_tile0(r, rho_, q0); } else tile_ = pm; } } while (0)
#define ATT_COMPUTE(KF, VF, rho_, tile_, valid_) do { \
        const int delta = r - (rho_); const int lo = delta < 0 ? 1 : 0; const int h1 = (128 - delta) >> 4; \
        const int h2 = ((delta & 3) == 0) ? ((512 - delta) >> 4) : -1; const int h3 = (delta == 0) ? 128 : -1; \
        f32x4 s = {0.f, 0.f, 0.f, 0.f}; \
        _Pragma("unroll") for (int kk = 0; kk < 4; ++kk) s = __builtin_amdgcn_mfma_f32_16x16x32_bf16(KF[kk], qf[kk], s, 0, 0, 0); \
        asm volatile("" : "+v"(s) : "v"(KF[0]), "v"(KF[1]), "v"(KF[2]), "v"(KF[3])); \
        const int dist = (q0 + r16) - ((tile_) * 16 + 4 * g); \
        const int lo_ = (valid_) ? lo : (1 << 20); \
        float mult[4], sv[4]; float tm = -INFINITY; \
        _Pragma("unroll") for (int i = 0; i < 4; ++i) { const int dd = dist - i; \
            int mu = (int)(dd <= h1) + (int)(dd <= h2) + (int)(dd <= h3); mu = (dd >= lo_) ? mu : 0; \
            mult[i] = (float)mu; sv[i] = (mu > 0) ? s[i] : -INFINITY; tm = fmaxf(tm, sv[i]); } \
        tm = fmaxf(tm, __shfl_xor(tm, 16)); tm = fmaxf(tm, __shfl_xor(tm, 32)); \
        const float m_new = fmaxf(m_run, tm); \
        if (__any(m_new > m_run)) { \
            const float alpha = (m_new == -INFINITY) ? 1.f : __builtin_amdgcn_exp2f(m_run - m_new); \
            l_run *= alpha; \
            _Pragma("unroll") for (int dt = 0; dt < 8; ++dt) o[dt] = o[dt] * alpha; \
            m_run = m_new; } \
        float p[4]; const float m_use = fmaxf(m_run, -1e30f); \
        _Pragma("unroll") for (int i = 0; i < 4; ++i) { p[i] = mult[i] * __builtin_amdgcn_exp2f(sv[i] - m_use); l_run += p[i]; } \
        u32x2 pw; pw.x = pk2(p[0], p[1]); pw.y = pk2(p[2], p[3]); \
        const s16x4 pb = __builtin_bit_cast(s16x4, pw); \
        _Pragma("unroll") for (int dt = 0; dt < 8; ++dt) o[dt] = __builtin_amdgcn_mfma_f32_16x16x16bf16_1k(VF[dt], pb, o[dt], 0, 0, 0); \
        asm volatile("" : "+v"(o[0]), "+v"(o[7]) : "v"(pb), "v"(VF[0]), "v"(VF[1]), "v"(VF[2]), "v"(VF[3]), "v"(VF[4]), "v"(VF[5]), "v"(VF[6]), "v"(VF[7])); } while (0)
    int prho = 0, ptile = att_tile0(r, 0, q0), crho = 0, ctile = ptile;
    s16x8 kfA[4], kfB[4], kfC[4]; s16x4 vfA[8], vfB[8], vfC[8];
    ATT_LOAD(kfA, vfA, prho, ptile); ATT_NEXT(prho, ptile);
    ATT_LOAD(kfB, vfB, prho, ptile); ATT_NEXT(prho, ptile);
    for (int step = 0; step < NT; step += 3) {
        ATT_LOAD(kfC, vfC, prho, ptile); ATT_NEXT(prho, ptile);
        ATT_COMPUTE(kfA, vfA, crho, ctile, true); ATT_NEXT(crho, ctile);
        ATT_LOAD(kfA, vfA, prho, ptile); ATT_NEXT(prho, ptile);
        ATT_COMPUTE(kfB, vfB, crho, ctile, (step + 1 < NT)); ATT_NEXT(crho, ctile);
        ATT_LOAD(kfB, vfB, prho, ptile); ATT_NEXT(prho, ptile);
        ATT_COMPUTE(kfC, vfC, crho, ctile, (step + 2 < NT)); ATT_NEXT(crho, ctile);
    }
#undef ATT_LOAD
#undef ATT_NEXT
#undef ATT_COMPUTE
    float l = l_run; l += __shfl_xor(l, 16); l += __shfl_xor(l, 32);
    const float inv = 1.f / l;
    const int t = 16 * (q0 + r16) + r;
    bf16_t* op = WS_PTR(bf16_t, WS_OATT) + (size_t)t * 1024 + h * 128 + 4 * g;
#pragma unroll
    for (int dt = 0; dt < 8; ++dt) { const f32x4 v = o[dt] * inv;
        u32x2 w; w.x = pk2(v[0], v[1]); w.y = pk2(v[2], v[3]); *(u32x2*)(op + 16 * dt) = w; }
}

__device__ __forceinline__ int samp_dist(int slot) { return slot < 129 ? slot : (slot < 258 ? 4 * (slot - 129) : 16 * (slot - 258)); }
__device__ __forceinline__ void sattn_item(const Params& P, int item, float* lf) {
    const int tid = threadIdx.x, wave = tid >> 6, b = item >> 3, h = item & 7;
    float* qs = lf; float* sc = lf + 128; float* red = lf + 640; float* po = lf + 704;
    const float* proj = WS_PTR(const float, WS_PROJS) + (size_t)b * NIN;
    if (tid < 128) { qs[tid] = proj[h * 128 + tid] * 0.08838834764831845f;
        P.out[O_WKS + b * 1024 + h * 128 + tid] = proj[1024 + h * 128 + tid]; P.out[O_WVS + b * 1024 + h * 128 + tid] = proj[2048 + h * 128 + tid]; }
    __syncthreads();
    const bool valid = tid < 387; const int d = samp_dist(tid);
    float s = -INFINITY;
    if (valid) { const float* kp = (d == 0) ? (proj + 1024 + h * 128) : (P.cache_k + (((size_t)b * PAST + (PAST - d)) * 8 + h) * 128);
        float a = 0.f;
#pragma unroll 16
        for (int j = 0; j < 32; ++j) { const f32x4 kv = ((const f32x4*)kp)[j]; const f32x4 qv = ((const f32x4*)qs)[j]; a += kv[0] * qv[0] + kv[1] * qv[1] + kv[2] * qv[2] + kv[3] * qv[3]; }
        s = a; }
    float m = s;
#pragma unroll
    for (int o = 1; o < 64; o <<= 1) m = fmaxf(m, __shfl_xor(m, o));
    if ((tid & 63) == 0) red[wave] = m;
    __syncthreads();
    m = red[0];
#pragma unroll
    for (int w = 1; w < 8; ++w) m = fmaxf(m, red[w]);
    const float p = valid ? __expf(s - m) : 0.f;
    sc[tid] = p;
    const float ps = wave_sum(p);
    __syncthreads();
    if ((tid & 63) == 0) red[8 + wave] = ps;
    __syncthreads();
    float tot = 0.f;
#pragma unroll
    for (int w = 0; w < 8; ++w) tot += red[8 + w];
    const int dq = tid & 31, kg = tid >> 5; f32x4 acc = {0.f, 0.f, 0.f, 0.f};
#pragma unroll
    for (int it = 0; it < 25; ++it) { const int j = kg + 16 * it;
        if (j < 387) { const int dj = samp_dist(j);
            const float* vp = (dj == 0) ? (proj + 2048 + h * 128) : (P.cache_v + (((size_t)b * PAST + (PAST - dj)) * 8 + h) * 128);
            const f32x4 vv = ((const f32x4*)vp)[dq]; const float pj = sc[j]; acc = acc + vv * pj; } }
    __syncthreads();
    ((f32x4*)po)[kg * 32 + dq] = acc;
    __syncthreads();
    if (tid < 128) { float o = 0.f;
#pragma unroll
        for (int q = 0; q < 16; ++q) o += po[q * 128 + tid];
        WS_PTR(float, WS_OATTS)[b * 1024 + h * 128 + tid] = o / tot; }
    __syncthreads();
}
__device__ __forceinline__ void shgrn_item(const Params& P, int item, float* lf) {
    const int tid = threadIdx.x, wave = tid >> 6, b = item >> 3, h = item & 7;
    float* qv = lf; float* fv = lf + 128; float* kv = lf + 256; float* po = lf + 384; float* red = lf + 896;
    const float* proj = WS_PTR(const float, WS_PROJS) + (size_t)b * NIN;
    if (tid < 128) { const int idx = h * 128 + tid; const float l0 = P.lb_logits[idx], l1 = P.lb_logits[1024 + idx];
        const float lbv = 1.f / (1.f + __expf(l1 - l0)); const float x = proj[4096 + idx];
        fv[tid] = lbv + (1.f - lbv) * sigmoidf_(x); kv[tid] = (1.f - lbv) * sigmoidf_(-x); qv[tid] = siluf_(proj[3072 + idx]); }
    __syncthreads();
    const int v = tid & 127, grp = tid >> 7; const float vv = proj[5120 + h * 128 + v]; float acc = 0.f;
    const size_t sb = ((size_t)(b * 8 + h) * 128) * 128;
#pragma unroll 16
    for (int k = grp * 32; k < grp * 32 + 32; ++k) { const float s = fv[k] * P.state_in[sb + (size_t)k * 128 + v] + kv[k] * vv; P.out[O_STS + sb + (size_t)k * 128 + v] = s; acc += qv[k] * s; }
    po[tid] = acc;
    __syncthreads();
    float o = 0.f;
    if (tid < 128) { o = po[tid] + po[tid + 128] + po[tid + 256] + po[tid + 384]; const float ss = wave_sum(o * o); if ((tid & 63) == 0) red[wave] = ss; }
    __syncthreads();
    if (tid < 128) { const float rstd = rsqrtf((red[0] + red[1]) * (1.f / 128.f) + EPS_);
        WS_PTR(float, WS_OHGS)[b * 1024 + h * 128 + tid] = o * rstd * P.hg_gain[tid] * siluf_(proj[6144 + h * 128 + tid]); }
    __syncthreads();
}

template <bool OUT> __device__ __forceinline__ void hgrn_item(const Params& P, int item, unsigned char* lds) {
    const int tid = threadIdx.x, wave = tid >> 6, lane = tid & 63, g = lane >> 4, r16 = lane & 15;
    const int h = item / NCH, c = item % NCH;
    bf16_t* Qs = (bf16_t*)lds; bf16_t* Ks = (bf16_t*)(lds + 17408); bf16_t* KHt = (bf16_t*)(lds + 34816); bf16_t* Vt = (bf16_t*)(lds + 51200);
    float* Ds = (float*)(lds + 67584); float* Os = (float*)(lds + 69632);
    const bf16_t* HG = WS_PTR(const bf16_t, WS_HG);
    f32x4 S[8];
    float* Ub = WS_PTR(float, WS_U) + ((size_t)(c * 8 + h) * 128) * 128 + 16 * wave + r16;
#pragma unroll
    for (int kt = 0; kt < 8; ++kt) {
        if (OUT && MK_VAR != 1) {
#pragma unroll
            for (int i = 0; i < 4; ++i) S[kt][i] = Ub[(size_t)(16 * kt + 4 * g + i) * 128];
        } else S[kt] = (f32x4){0.f, 0.f, 0.f, 0.f};
    }
    float dtot = 1.f;
    unsigned short fx[16], vx[16], qx[16];
#define HG_LOADS(t0_) do { const bf16_t* hg_ = HG + (size_t)((t0_) + (tid >> 7) * 16) * 4096 + h * 128 + (tid & 127); \
        _Pragma("unroll") for (int t = 0; t < 16; ++t) { fx[t] = hg_[(size_t)t * 4096 + 1024]; vx[t] = hg_[(size_t)t * 4096 + 2048]; if (OUT) qx[t] = hg_[(size_t)t * 4096]; } } while (0)
    HG_LOADS(c * 256);
    f32x4 gnv[4];
    if (OUT) {
#pragma unroll
        for (int q = 0; q < 4; ++q) gnv[q] = ((const f32x4*)(P.hg_gain + 16 * (tid & 7)))[q]; }
    for (int sc = 0; sc < 4; ++sc) {
    const int t0 = c * 256 + sc * 64;
    u32x4 ga = {0u, 0u, 0u, 0u}, gb = ga;
    if (OUT) { const u32x4* gp = (const u32x4*)(HG + (size_t)(t0 + (tid >> 3)) * 4096 + 3072 + h * 128 + 16 * (tid & 7)); ga = gp[0]; gb = gp[1]; }
    {
        const int k = tid & 127, sb = tid >> 7;
        const float l0 = P.lb_logits[h * 128 + k], l1 = P.lb_logits[1024 + h * 128 + k];
        const float lbk = __builtin_amdgcn_rcpf(1.f + __expf(l1 - l0));
        float fv_[16], kvv[16], Pt[16]; float run = 1.f;
#pragma unroll
        for (int t = 0; t < 16; ++t) { const float x = bf2f(fx[t]); const float sg = __builtin_amdgcn_rcpf(1.f + __expf(-x));
            fv_[t] = lbk + (1.f - lbk) * sg; kvv[t] = (1.f - lbk) * (1.f - sg); run *= fv_[t]; Pt[t] = run; }
        float khat[16]; float sfx = 1.f;
#pragma unroll
        for (int t = 15; t >= 0; --t) { khat[t] = kvv[t] * sfx; sfx *= fv_[t]; }
        unsigned khp[8], vtp[8];
#pragma unroll
        for (int t = 0; t < 16; t += 2) {
            if (OUT) {
                const float qa = siluf_(bf2f(qx[t])), qb = siluf_(bf2f(qx[t + 1]));
                Qs[(sb * 16 + t) * 136 + k] = f2bf(qa * Pt[t]); Qs[(sb * 16 + t + 1) * 136 + k] = f2bf(qb * Pt[t + 1]);
                Ks[(sb * 16 + t) * 136 + k] = f2bf(kvv[t] * __builtin_amdgcn_rcpf(Pt[t])); Ks[(sb * 16 + t + 1) * 136 + k] = f2bf(kvv[t + 1] * __builtin_amdgcn_rcpf(Pt[t + 1]));
            }
            khp[t >> 1] = pk2(khat[t], khat[t + 1]);
            vtp[t >> 1] = (unsigned)vx[t] | ((unsigned)vx[t + 1] << 16);
        }
        u32x4* kd = (u32x4*)(KHt + (sb * 128 + k) * 16); kd[0] = (u32x4){khp[0], khp[1], khp[2], khp[3]}; kd[1] = (u32x4){khp[4], khp[5], khp[6], khp[7]};
        u32x4* vd = (u32x4*)(Vt + (sb * 128 + k) * 16); vd[0] = (u32x4){vtp[0], vtp[1], vtp[2], vtp[3]}; vd[1] = (u32x4){vtp[4], vtp[5], vtp[6], vtp[7]};
        Ds[sb * 128 + k] = run;
    }
    __syncthreads();
    if (sc < 3) HG_LOADS(t0 + 64);
    float gg[16];
    if (OUT) {
        const unsigned gw[8] = {ga.x, ga.y, ga.z, ga.w, gb.x, gb.y, gb.z, gb.w};
#pragma unroll
        for (int q = 0; q < 4; ++q) { const f32x4 gn = gnv[q];
            gg[4 * q] = gn[0] * siluf_(bflo(gw[2 * q])); gg[4 * q + 1] = gn[1] * siluf_(bfhi(gw[2 * q]));
            gg[4 * q + 2] = gn[2] * siluf_(bflo(gw[2 * q + 1])); gg[4 * q + 3] = gn[3] * siluf_(bfhi(gw[2 * q + 1])); } }
    for (int sb = 0; sb < 4; ++sb) {
        const s16x4 vA = *(const s16x4*)(Vt + (sb * 128 + 16 * wave + r16) * 16 + 4 * g);
        if (OUT) {
            s16x8 qB[4], kA[4];
#pragma unroll
            for (int kk = 0; kk < 4; ++kk) {
                const s16x4 ql = *(const s16x4*)(Qs + (sb * 16 + r16) * 136 + 32 * kk + 4 * g), qh = *(const s16x4*)(Qs + (sb * 16 + r16) * 136 + 32 * kk + 16 + 4 * g);
                qB[kk] = __builtin_shufflevector(ql, qh, 0, 1, 2, 3, 4, 5, 6, 7);
                const s16x4 kl = *(const s16x4*)(Ks + (sb * 16 + r16) * 136 + 32 * kk + 4 * g), kh = *(const s16x4*)(Ks + (sb * 16 + r16) * 136 + 32 * kk + 16 + 4 * g);
                kA[kk] = __builtin_shufflevector(kl, kh, 0, 1, 2, 3, 4, 5, 6, 7);
            }
            f32x4 oT = {0.f, 0.f, 0.f, 0.f}, aT = {0.f, 0.f, 0.f, 0.f};
#pragma unroll
            for (int kk = 0; kk < 4; ++kk) {
                u32x4 sw; sw.x = pk2(S[2 * kk][0], S[2 * kk][1]); sw.y = pk2(S[2 * kk][2], S[2 * kk][3]); sw.z = pk2(S[2 * kk + 1][0], S[2 * kk + 1][1]); sw.w = pk2(S[2 * kk + 1][2], S[2 * kk + 1][3]);
                const s16x8 sA = __builtin_bit_cast(s16x8, sw);
                oT = __builtin_amdgcn_mfma_f32_16x16x32_bf16(sA, qB[kk], oT, 0, 0, 0);
                aT = __builtin_amdgcn_mfma_f32_16x16x32_bf16(kA[kk], qB[kk], aT, 0, 0, 0);
                asm volatile("" : "+v"(oT), "+v"(aT) : "v"(sA), "v"(qB[kk]), "v"(kA[kk]));
            }
            SETTLE();
#pragma unroll
            for (int i = 0; i < 4; ++i) if (4 * g + i > r16) aT[i] = 0.f;
            u32x2 aw; aw.x = pk2(aT[0], aT[1]); aw.y = pk2(aT[2], aT[3]);
#if MK_SUB != 1
            { const s16x4 aB = __builtin_bit_cast(s16x4, aw);
              oT = __builtin_amdgcn_mfma_f32_16x16x16bf16_1k(vA, aB, oT, 0, 0, 0);
              asm volatile("" : "+v"(oT) : "v"(vA), "v"(aB)); }
#else
            if (aw.x == 0x12345678u && aw.y == 0x9abcdef1u) oT[0] += 1.f;
#endif
            SETTLE();
            *(f32x4*)(Os + (sb * 16 + r16) * 132 + 16 * wave + 4 * g) = oT;
#if MK_VAR == 4
            { u32x2 w; w.x = pk2(oT[0], oT[1]); w.y = pk2(oT[2], oT[3]);
              *(u32x2*)(WS_PTR(bf16_t, WS_MRG) + (size_t)(t0 + sb * 16 + r16) * 2048 + 1024 + h * 128 + 16 * wave + 4 * g) = w; }
#endif
        }
#pragma unroll
        for (int kt = 0; kt < 8; ++kt) {
            const f32x4 d4 = *(const f32x4*)(Ds + sb * 128 + 16 * kt + 4 * g);
            const s16x4 khA = *(const s16x4*)(KHt + (sb * 128 + 16 * kt + r16) * 16 + 4 * g);
            S[kt] = __builtin_amdgcn_mfma_f32_16x16x16bf16_1k(khA, vA, S[kt] * d4, 0, 0, 0);
            asm volatile("" : "+v"(S[kt]) : "v"(khA), "v"(vA));
        }
        SETTLE();
    }
    if (!OUT) {
        if (tid < 128) dtot *= Ds[tid] * Ds[128 + tid] * Ds[256 + tid] * Ds[384 + tid];
    } else {
        __syncthreads();
        const int t = tid >> 3, j = tid & 7;
        const float* orow = Os + t * 132 + 16 * j;
        f32x4 ov[4]; float ss = 0.f;
#pragma unroll
        for (int q = 0; q < 4; ++q) { ov[q] = ((const f32x4*)orow)[q]; ss += ov[q][0] * ov[q][0] + ov[q][1] * ov[q][1] + ov[q][2] * ov[q][2] + ov[q][3] * ov[q][3]; }
        ss += __shfl_xor(ss, 1); ss += __shfl_xor(ss, 2); ss += __shfl_xor(ss, 4);
        const float rstd = rsqrtf(ss * (1.f / 128.f) + EPS_);
        unsigned ow[8];
#pragma unroll
        for (int q = 0; q < 4; ++q) {
            const float a0 = ov[q][0] * rstd * gg[4 * q], a1 = ov[q][1] * rstd * gg[4 * q + 1];
            const float a2 = ov[q][2] * rstd * gg[4 * q + 2], a3 = ov[q][3] * rstd * gg[4 * q + 3];
            ow[2 * q] = pk2(a0, a1); ow[2 * q + 1] = pk2(a2, a3); }
        u32x4* mp = (u32x4*)(WS_PTR(bf16_t, WS_MRG) + (size_t)(t0 + t) * 2048 + 1024 + h * 128 + 16 * j);
#if MK_VAR != 4
        mp[0] = (u32x4){ow[0], ow[1], ow[2], ow[3]}; mp[1] = (u32x4){ow[4], ow[5], ow[6], ow[7]};
#else
        if (ow[0] == 0x12345678u && ow[7] == 0x9abcdef0u) mp[0] = (u32x4){ow[0], ow[1], ow[2], ow[3]};
#endif
    }
    __syncthreads();
    }
#undef HG_LOADS
    if (!OUT) {
#pragma unroll
        for (int kt = 0; kt < 8; ++kt)
#pragma unroll
            for (int i = 0; i < 4; ++i) Ub[(size_t)(16 * kt + 4 * g + i) * 128] = S[kt][i];
        if (tid < 128) WS_PTR(float, WS_DD)[(size_t)(c * 8 + h) * 128 + tid] = dtot;
    }
}

__device__ __forceinline__ void gemm_stagger(int ticks) {
#if MK_STAG
    if ((xb_xcc_id() & 1u) && ticks > 0) { const unsigned long long t0 = __builtin_amdgcn_s_memrealtime(); while ((long long)(__builtin_amdgcn_s_memrealtime() - t0) < ticks) __builtin_amdgcn_s_sleep(8); }
#endif
}
__device__ __forceinline__ void phase_run(const Params& P, int ph, unsigned char* lds) {
    const int tid = threadIdx.x, wave = __builtin_amdgcn_readfirstlane(tid >> 6), lane = tid & 63;
    const int gw = blockIdx.x * 8 + wave, NGW = gridDim.x * 8;
    float* lf = (float*)lds;
    pg8::StaticOrder SO;
#ifdef ONLY_PH
    if (ph != ONLY_PH) return; ph = ONLY_PH;
#endif
    switch (ph) {
    case 0: {
        float* scr = (float*)(lds + wave * 8448);
        constexpr int I_IN = 32 * 224, I_OUT = 32 * 64, I_G = 32 * 176, I_D = 88 * 64;
        for (int it = gw; it < I_IN + I_OUT + 2 * I_G + I_D; it += NGW) {
            int r = it;
            if (r < I_G) { transpose_item(P.w_gate, 2048, DFF, WS_PTR(bf16_t, WS_WGU), 128, 256, 0, scr, r, lane); continue; } r -= I_G;
            if (r < I_G) { transpose_item(P.w_up, 2048, DFF, WS_PTR(bf16_t, WS_WGU), 128, 256, 128, scr, r, lane); continue; } r -= I_G;
            if (r < I_D) { transpose_item(P.w_down, DFF, 2048, WS_PTR(bf16_t, WS_WD), 1 << 20, 0, 0, scr, r, lane); continue; } r -= I_D;
            if (r < I_OUT) { transpose_item(P.w_out, 2048, 2048, WS_PTR(bf16_t, WS_WOUT), 1 << 20, 0, 0, scr, r, lane); continue; } r -= I_OUT;
            transpose_item(P.w_in, 2048, NIN, WS_PTR(bf16_t, WS_WIN), 1 << 20, 0, 0, scr, r, lane);
        }
        { int row = gw;
          for (; row + NGW < T_; row += 2 * NGW) rms_row2_bf16(P.x_prompt + (size_t)row * 2048, P.n_pre_mix, WS_PTR(bf16_t, WS_H) + (size_t)row * 2048, (size_t)NGW * 2048, lane);
          for (; row < T_ + NBS; row += NGW) {
            if (row < T_) rms_row_bf16(P.x_prompt + (size_t)row * 2048, P.n_pre_mix, WS_PTR(bf16_t, WS_H) + (size_t)row * 2048, lane);
            else rms_row_bf16(P.x_sample + (size_t)(row - T_) * 2048, P.n_pre_mix, WS_PTR(bf16_t, WS_HS) + (size_t)(row - T_) * 2048, lane);
          } }
    } break;
    case 1: {
        float* projs = WS_PTR(float, WS_PROJS);
        { int i0 = -1, istep = 0;
          if (gridDim.x == 256) { const int x = blockIdx.x & 7, j = blockIdx.x >> 3;
              if (x < 6) { i0 = j * 6 + x; istep = 192; if (i0 + 192 >= 384) {} } else { i0 = 384 + j * 2 + (x - 6); istep = 1 << 20; } }
          if (gridDim.x == 256 && (blockIdx.x & 7) < 6) {
              skinny_gemm(WS_PTR(const bf16_t, WS_HS), WS_PTR(const bf16_t, WS_WIN), 2048, 384 * 16, lf, [=](int row, int col, float v) { projs[(size_t)row * NIN + col] = v; }, i0, istep);
          } else
              skinny_gemm(WS_PTR(const bf16_t, WS_HS), WS_PTR(const bf16_t, WS_WIN), 2048, NIN, lf, [=](int row, int col, float v) { projs[(size_t)row * NIN + col] = v; }, i0, istep); }
        pg8::Gemm gm{WS_PTR(const bf16_t, WS_H), WS_PTR(const bf16_t, WS_WIN), T_, NIN, 2048};
        SO.init(T_, NIN, (int)gridDim.x, (int)blockIdx.x);
        EpiIn E{WS_PTR(bf16_t, WS_QC), WS_PTR(bf16_t, WS_KC), WS_PTR(bf16_t, WS_VT), WS_PTR(bf16_t, WS_HG), P.out + O_WKP, P.out + O_WVP, 0.08838834764831845f * 1.4426950408889634f};
        gemm_stagger(800);
        RotOrder RO; RO.init(T_, NIN, (int)gridDim.x, (int)blockIdx.x);
        pg8::gemm_phase<EpiIn, RotOrder, false>((PG8_LAS unsigned char*)lds, gm, RO, E, nullptr);
    } break;
    case 2: {
        if ((gridDim.x & 7) == 0) {
            const int hh = blockIdx.x & 7, lw = (blockIdx.x >> 3) * 8 + wave, nlw = gridDim.x;
            for (int j = lw; j < 1024; j += nlw) attn_item(P, hh * 1024 + j, lane);
        } else {
            for (int it = gw; it < 8192; it += NGW) attn_item(P, it, lane);
        }
        __syncthreads();
        for (int it = blockIdx.x; it < 256; it += gridDim.x) { sattn_item(P, it, lf); shgrn_item(P, it, lf); }
        for (int it = blockIdx.x; it < 8 * NCH; it += gridDim.x) hgrn_item<false>(P, it, lds);
    } break;
    case 3: {
        float* U = WS_PTR(float, WS_U); const float* DD = WS_PTR(const float, WS_DD);
        for (int e = blockIdx.x * 512 + tid; e < 8 * 128 * 128; e += gridDim.x * 512) {
            const int hk = e >> 7; float S = 0.f;
#pragma unroll 32
            for (int c = 0; c < NCH; ++c) { const float u = U[(size_t)c * 131072 + e]; const float d = DD[c * 1024 + hk]; U[(size_t)c * 131072 + e] = S; S = d * S + u; }
            P.out[O_STP + e] = S;
        }
        if (gw < NBS) {
            const float* oa = WS_PTR(const float, WS_OATTS) + gw * 1024; const float* oh = WS_PTR(const float, WS_OHGS) + gw * 1024; bf16_t* mr = WS_PTR(bf16_t, WS_MRGS) + gw * 2048;
            f32x4 v[4]; float ss = 0.f;
#pragma unroll
            for (int j = 0; j < 4; ++j) { v[j] = ((const f32x4*)oa)[lane + 64 * j]; ss += v[j][0] * v[j][0] + v[j][1] * v[j][1] + v[j][2] * v[j][2] + v[j][3] * v[j][3]; }
            const float r = rsqrtf(wave_sum(ss) * (1.f / 1024.f) + EPS_);
#pragma unroll
            for (int j = 0; j < 4; ++j) { const f32x4 gv = ((const f32x4*)P.attn_gain)[lane + 64 * j]; const f32x4 hv = ((const f32x4*)oh)[lane + 64 * j];
                u32x2 w; w.x = pk2(v[j][0] * r * gv[0], v[j][1] * r * gv[1]); w.y = pk2(v[j][2] * r * gv[2], v[j][3] * r * gv[3]); ((u32x2*)mr)[lane + 64 * j] = w;
                u32x2 w2; w2.x = pk2(hv[0], hv[1]); w2.y = pk2(hv[2], hv[3]); ((u32x2*)(mr + 1024))[lane + 64 * j] = w2; }
        }
    } break;
    case 4: {
        float* mixs = WS_PTR(float, WS_MIXS);
        skinny_gemm(WS_PTR(const bf16_t, WS_MRGS), WS_PTR(const bf16_t, WS_WOUT), 2048, 2048, lf, [=](int row, int col, float v) { mixs[(size_t)row * 2048 + col] = v; });
        for (int it = blockIdx.x; it < 8 * NCH; it += gridDim.x) hgrn_item<true>(P, it, lds);
        for (int row0 = gw; row0 < T_; row0 += 4 * NGW) {
            u32x4 w[4][2]; float ss[4];
#pragma unroll
            for (int q4 = 0; q4 < 4; ++q4) { const int row = row0 + q4 * NGW; const int rr = row < T_ ? row : row0;
                const u32x4* ip = (const u32x4*)(WS_PTR(const bf16_t, WS_OATT) + (size_t)rr * 1024) + lane * 2; w[q4][0] = ip[0]; w[q4][1] = ip[1]; }
#pragma unroll
            for (int q4 = 0; q4 < 4; ++q4) { float a = 0.f;
#pragma unroll
                for (int q = 0; q < 2; ++q) { const u32x4 v = w[q4][q];
                    a += bflo(v.x) * bflo(v.x) + bfhi(v.x) * bfhi(v.x) + bflo(v.y) * bflo(v.y) + bfhi(v.y) * bfhi(v.y) + bflo(v.z) * bflo(v.z) + bfhi(v.z) * bfhi(v.z) + bflo(v.w) * bflo(v.w) + bfhi(v.w) * bfhi(v.w); }
                ss[q4] = a; }
#pragma unroll
            for (int q4 = 0; q4 < 4; ++q4) ss[q4] = rsqrtf(wave_sum(ss[q4]) * (1.f / 1024.f) + EPS_);
#pragma unroll
            for (int q4 = 0; q4 < 4; ++q4) { const int row = row0 + q4 * NGW; if (row >= T_) break; const float r = ss[q4];
                u32x4* op = (u32x4*)(WS_PTR(bf16_t, WS_MRG) + (size_t)row * 2048) + lane * 2;
#pragma unroll
                for (int q = 0; q < 2; ++q) { const u32x4 v = w[q4][q]; const f32x4 g0 = ((const f32x4*)P.attn_gain)[lane * 4 + q * 2], g1 = ((const f32x4*)P.attn_gain)[lane * 4 + q * 2 + 1];
                    u32x4 o; o.x = pk2(bflo(v.x) * r * g0[0], bfhi(v.x) * r * g0[1]); o.y = pk2(bflo(v.y) * r * g0[2], bfhi(v.y) * r * g0[3]);
                    o.z = pk2(bflo(v.z) * r * g1[0], bfhi(v.z) * r * g1[1]); o.w = pk2(bflo(v.w) * r * g1[2], bfhi(v.w) * r * g1[3]); op[q] = o; } }
        }
    } break;
    case 5: {
        if (gw < NBS) post_mix_row(P.x_sample + (size_t)gw * 2048, WS_PTR(const float, WS_MIXS) + (size_t)gw * 2048, P.n_post_mix, P.n_pre_ffn, P.out + O_YS + (size_t)gw * 2048, WS_PTR(bf16_t, WS_H2S) + (size_t)gw * 2048, lane);
        pg8::Gemm gm{WS_PTR(const bf16_t, WS_MRG), WS_PTR(const bf16_t, WS_WOUT), T_, 2048, 2048};
        SO.init(T_, 2048, (int)gridDim.x, (int)blockIdx.x);
        EpiBf16P E{WS_PTR(bf16_t, WS_MIX), 2048};
        gemm_stagger(800);
        pg8::gemm_phase<EpiBf16P, pg8::StaticOrder, false>((PG8_LAS unsigned char*)lds, gm, SO, E, nullptr);
    } break;
    case 6: {
        skinny_gu(WS_PTR(const bf16_t, WS_H2S), WS_PTR(const bf16_t, WS_WGU), WS_PTR(bf16_t, WS_FFS), lf);
#if MK_DBG == 1
        for (int row = gw; row < T_; row += NGW) for (int c = lane; c < 2048; c += 64) P.out[O_YP + (size_t)row * 2048 + c] = bf2f(WS_PTR(const bf16_t, WS_MRG)[(size_t)row * 2048 + c]);
#elif MK_DBG == 4
        for (int row = gw; row < T_; row += NGW) for (int c = lane; c < 2048; c += 64) P.out[O_YP + (size_t)row * 2048 + c] = bf2f(WS_PTR(const bf16_t, WS_HG)[(size_t)row * 4096 + c]);
#elif MK_DBG == 5
        for (int row = gw; row < T_; row += NGW) for (int c = lane; c < 2048; c += 64) P.out[O_YP + (size_t)row * 2048 + c] = (c >= 1024) ? 0.f : bf2f(WS_PTR(const bf16_t, WS_OATT)[(size_t)row * 1024 + c]);
#elif MK_DBG == 6
        for (size_t i = (size_t)blockIdx.x * 512 + tid; i < (size_t)T_ * 2048; i += (size_t)gridDim.x * 512) P.out[O_YP + i] = WS_PTR(const float, WS_U)[i];
#elif MK_DBG == 7
        for (int row = gw; row < T_; row += NGW) for (int c = lane; c < 2048; c += 64) P.out[O_YP + (size_t)row * 2048 + c] = bf2f(WS_PTR(const bf16_t, WS_HG)[(size_t)row * 4096 + 2048 + c]);
#elif MK_DBG == 2
        for (int row = gw; row < T_; row += NGW) for (int c = lane; c < 2048; c += 64) P.out[O_YP + (size_t)row * 2048 + c] = (c < 1024) ? 0.f : bf2f(WS_PTR(const bf16_t, WS_MRG)[(size_t)row * 2048 + c]);
#else
        { int row = gw;
          for (; row + NGW < T_; row += 2 * NGW)
            post_mix_row2(P.x_prompt + (size_t)row * 2048, WS_PTR(const bf16_t, WS_MIX) + (size_t)row * 2048, P.n_post_mix, P.n_pre_ffn, WS_PTR(bf16_t, WS_MRG) + (size_t)row * 2048, WS_PTR(bf16_t, WS_H) + (size_t)row * 2048, (size_t)NGW * 2048, lane);
          for (; row < T_; row += NGW)
            post_mix_row(P.x_prompt + (size_t)row * 2048, WS_PTR(const bf16_t, WS_MIX) + (size_t)row * 2048, P.n_post_mix, P.n_pre_ffn, WS_PTR(bf16_t, WS_MRG) + (size_t)row * 2048, WS_PTR(bf16_t, WS_H) + (size_t)row * 2048, lane); }
#endif
    } break;
    case 7: {
        float* ffos = WS_PTR(float, WS_FFOS);
        { int i0 = -1, istep = 0;
          if (gridDim.x == 256) { const int x = blockIdx.x & 7, j = blockIdx.x >> 3; i0 = (x < 4) ? (j * 4 + x) : (1 << 20); istep = 1 << 20; }
          skinny_gemm(WS_PTR(const bf16_t, WS_FFS), WS_PTR(const bf16_t, WS_WD), DFF, 2048, lf, [=](int row, int col, float v) { ffos[(size_t)row * 2048 + col] = v; }, i0, istep); }
        pg8::Gemm gm{WS_PTR(const bf16_t, WS_H), WS_PTR(const bf16_t, WS_WGU), T_, 2 * DFF, 2048};
        SO.init(T_, 2 * DFF, (int)gridDim.x, (int)blockIdx.x);
        EpiSwiGLU E{WS_PTR(bf16_t, WS_FF)};
        gemm_stagger(500);
        pg8::gemm_phase<EpiSwiGLU, pg8::StaticOrder, false>((PG8_LAS unsigned char*)lds, gm, SO, E, nullptr);
    } break;
    case 8: {
        if (gw < NBS) final_row(P.out + O_YS + (size_t)gw * 2048, WS_PTR(const float, WS_FFOS) + (size_t)gw * 2048, P.n_post_ffn, P.out + O_YS + (size_t)gw * 2048, lane);
        pg8::Gemm gm{WS_PTR(const bf16_t, WS_FF), WS_PTR(const bf16_t, WS_WD), T_, 2048, DFF};
        SO.init(T_, 2048, (int)gridDim.x, (int)blockIdx.x);
        EpiBf16P E{WS_PTR(bf16_t, WS_MIX), 2048};
        gemm_stagger(800);
        pg8::gemm_phase<EpiBf16P, pg8::StaticOrder, false>((PG8_LAS unsigned char*)lds, gm, SO, E, nullptr);
    } break;
    case 9: {
        { int row = gw;
          for (; row + NGW < T_; row += 2 * NGW)
            final_row2(WS_PTR(const bf16_t, WS_MRG) + (size_t)row * 2048, WS_PTR(const bf16_t, WS_MIX) + (size_t)row * 2048, P.n_post_ffn, P.out + O_YP + (size_t)row * 2048, (size_t)NGW * 2048, lane);
          for (; row < T_; row += NGW)
            final_row(WS_PTR(const bf16_t, WS_MRG) + (size_t)row * 2048, WS_PTR(const bf16_t, WS_MIX) + (size_t)row * 2048, P.n_post_ffn, P.out + O_YP + (size_t)row * 2048, lane); }
    } break;
    default: break;
    }
}

__global__ __launch_bounds__(512, 2) void hymba_fwd(Params P) {
    extern __shared__ __attribute__((aligned(16))) unsigned char shm[];
    cg::grid_group grid = cg::this_grid();
#ifdef TEST_NOLOOP
    phase_run(P, ONLY_PH, shm);
#else
    volatile LAS unsigned* xst = (volatile LAS unsigned*)(shm + 131072);
    if (threadIdx.x < 4) xst[threadIdx.x] = 0u;
    __syncthreads();
    XcdBarrier xb = xcd_barrier_post((unsigned*)(P.ws + WS_BAR), xst);
#if MK_TIMER
    unsigned long long tsv[11]; tsv[0] = __builtin_amdgcn_s_memrealtime();
#define RUN_PH(n) if (P.ph_lo <= n && n < P.ph_hi) { phase_run(P, n, shm); grid.sync(); tsv[n + 1] = __builtin_amdgcn_s_memrealtime(); }
#else
#define RUN_PH(n) if (P.ph_lo <= n && n < P.ph_hi) { phase_run(P, n, shm); if (n + 1 < P.ph_hi) { if (n == MK_CGSEAM) grid.sync(); else xcd_barrier(xb); } }
#endif
    RUN_PH(0) RUN_PH(1) RUN_PH(2) RUN_PH(3) RUN_PH(4) RUN_PH(5) RUN_PH(6) RUN_PH(7) RUN_PH(8) RUN_PH(9)
#if MK_XSYNC
    for (int i = 0; i < MK_XSYNC; ++i) grid.sync();
#endif
    if (P.ph_hi > 1000) grid.sync();
#if MK_TIMER
    if (blockIdx.x == 0) {
        float d[10];
#pragma unroll
        for (int i = 0; i < 10; ++i) d[i] = (float)(tsv[i + 1] - tsv[i]) * 0.01f;
        const float* tw = WS_PTR(const float, WS_SSQ); (void)tw;
        const float T1 = MK_T1, T2 = MK_T2;
        if (threadIdx.x == 0) P.out[O_YS] += T1 * 0.01f;
        for (int i = threadIdx.x; i < 32768; i += 512) P.out[O_WKS + i] += T2 * 0.001f;
    }
#endif
#endif
}

extern "C" void kernel_launch(void* const* d_in, const int* in_sizes, int n_in, void* d_out, int out_size, void* d_ws, size_t ws_size, hipStream_t stream) {
    static int grid = 0;
    if (grid == 0) {
        if (ws_size < WS_END) { fprintf(stderr, "kernel_launch: workspace too small (%zu < %zu)\n", ws_size, (size_t)WS_END); grid = -1; return; }
        int dev = 0, cus = 0, per_cu = 0;
        hipGetDevice(&dev);
        hipDeviceGetAttribute(&cus, hipDeviceAttributeMultiprocessorCount, dev);
        if (hipFuncSetAttribute((const void*)hymba_fwd, hipFuncAttributeMaxDynamicSharedMemorySize, LDS_BYTES) != hipSuccess) { fprintf(stderr, "kernel_launch: hipFuncSetAttribute failed\n"); grid = -1; return; }
        if (hipOccupancyMaxActiveBlocksPerMultiprocessor(&per_cu, (const void*)hymba_fwd, 512, LDS_BYTES) != hipSuccess || per_cu < 1) { fprintf(stderr, "kernel_launch: occupancy query says %d\n", per_cu); per_cu = 1; }
        (void)hipGetLastError();
        grid = cus;
    }
    if (grid < 0) return;
    Params p{};
    p.x_prompt = (const float*)d_in[0]; p.x_sample = (const float*)d_in[1]; p.cache_k = (const float*)d_in[2]; p.cache_v = (const float*)d_in[3]; p.state_in = (const float*)d_in[4];
    p.n_pre_mix = (const float*)d_in[5]; p.w_in = (const float*)d_in[6]; p.lb_logits = (const float*)d_in[7]; p.attn_gain = (const float*)d_in[8]; p.hg_gain = (const float*)d_in[9];
    p.w_out = (const float*)d_in[10]; p.n_post_mix = (const float*)d_in[11]; p.n_pre_ffn = (const float*)d_in[12]; p.w_gate = (const float*)d_in[13]; p.w_up = (const float*)d_in[14];
    p.w_down = (const float*)d_in[15]; p.n_post_ffn = (const float*)d_in[16];
    p.out = (float*)d_out; p.ws = (unsigned char*)d_ws;
    if (hipMemsetAsync((char*)d_ws + WS_BAR, 0, 3456 * 4, stream) != hipSuccess) { fprintf(stderr, "kernel_launch: barrier memset failed\n"); return; }
#if MK_FUSED
    p.ph_lo = 0; p.ph_hi = 10;
    { void* args[] = {&p}; hipError_t e = hipLaunchCooperativeKernel((const void*)hymba_fwd, dim3(grid), dim3(512), args, LDS_BYTES, stream);
      if (e != hipSuccess) fprintf(stderr, "cooperative launch failed: %s (grid %d)\n", hipGetErrorString(e), grid); }
#else
    for (int ph = 0; ph < MK_NPH; ++ph) { p.ph_lo = ph; p.ph_hi = ph + 1; void* args[] = {&p};
      hipError_t e = hipLaunchCooperativeKernel((const void*)hymba_fwd, dim3(grid), dim3(512), args, LDS_BYTES, stream);
      if (e != hipSuccess) fprintf(stderr, "launch %d failed: %s (grid %d)\n", ph, hipGetErrorString(e), grid); }
#endif
}
```

```cpp
#include <hip/hip_runtime.h>
#include <hip/hip_cooperative_groups.h>
#include <cstdio>
namespace cg = cooperative_groups;

#ifndef MK_SETTLE
#define MK_SETTLE 0
#endif
#ifndef MK_VAR
#define MK_VAR 0
#endif
#ifndef MK_SUB
#define MK_SUB 0
#endif
#ifndef MK_TIMER
#define MK_TIMER 0
#define MK_T1 (d[0])
#define MK_T2 (d[3])
#endif
#ifndef MK_ATTPROBE
#define MK_ATTPROBE 0
#endif
#ifndef MK_XSYNC
#define MK_XSYNC 0
#endif
#ifndef MK_CGSEAM
#define MK_CGSEAM (-1)
#endif
#ifndef MK_STAG
#define MK_STAG 0
#endif
#ifndef MK_DBG
#define MK_DBG 0
#endif
#ifndef MK_NPH
#define MK_NPH 10
#endif
#ifndef MK_FUSED
#define MK_FUSED 1
#endif

typedef unsigned short bf16_t;
typedef short s16x8 __attribute__((ext_vector_type(8)));
typedef short s16x4 __attribute__((ext_vector_type(4)));
typedef float f32x4 __attribute__((ext_vector_type(4)));
typedef unsigned u32x4 __attribute__((ext_vector_type(4)));
typedef unsigned u32x2 __attribute__((ext_vector_type(2)));

constexpr int T_ = 16384, D_ = 2048, NIN = 7168, DFF = 5632, NBS = 32, PAST = 2048;
constexpr int NCH = 64;
constexpr float EPS_ = 1e-6f;
constexpr int LDS_BYTES = 131072 + 256;

constexpr size_t WS_WIN = 0;
constexpr size_t WS_WOUT = WS_WIN + (size_t)NIN * D_ * 2;
constexpr size_t WS_WGU = WS_WOUT + (size_t)D_ * D_ * 2;
constexpr size_t WS_WD = WS_WGU + (size_t)2 * DFF * D_ * 2;
constexpr size_t WS_H = WS_WD + (size_t)D_ * DFF * 2;
constexpr size_t WS_QC = WS_H + (size_t)T_ * D_ * 2;
constexpr size_t WS_KC = WS_QC + (size_t)T_ * 1024 * 2;
constexpr size_t WS_VT = WS_KC + (size_t)T_ * 1024 * 2;
constexpr size_t WS_HG = WS_VT + (size_t)T_ * 1024 * 2;
constexpr size_t WS_FF = WS_QC;
constexpr size_t WS_OATT = WS_HG + (size_t)T_ * 4096 * 2;
constexpr size_t WS_U = WS_OATT + (size_t)T_ * 1024 * 2;
constexpr size_t WS_DD = WS_U + (size_t)NCH * 8 * 128 * 128 * 4;
constexpr size_t WS_MRG = WS_DD + (size_t)NCH * 1024 * 4;
constexpr size_t WS_MIX = WS_MRG + (size_t)T_ * D_ * 2;
constexpr size_t WS_SSQ = WS_MIX + (size_t)T_ * D_ * 4;
constexpr size_t WS_S0 = WS_SSQ + (size_t)T_ * 4;
constexpr size_t WS_HS = WS_S0;
constexpr size_t WS_PROJS = WS_HS + 32 * 2048 * 2;
constexpr size_t WS_OATTS = WS_PROJS + 32 * 7168 * 4;
constexpr size_t WS_OHGS = WS_OATTS + 32 * 1024 * 4;
constexpr size_t WS_MRGS = WS_OHGS + 32 * 1024 * 4;
constexpr size_t WS_MIXS = WS_MRGS + 32 * 2048 * 2;
constexpr size_t WS_H2S = WS_MIXS + 32 * 2048 * 4;
constexpr size_t WS_FFS = WS_H2S + 32 * 2048 * 2;
constexpr size_t WS_FFOS = WS_FFS + 32 * 5632 * 2;
constexpr size_t WS_BAR = WS_FFOS + 32 * 2048 * 4;
constexpr size_t WS_END = WS_BAR + 3456 * 4 + 256;

constexpr size_t O_YP = 0;
constexpr size_t O_YS = O_YP + (size_t)T_ * D_;
constexpr size_t O_WKP = O_YS + 32 * 2048;
constexpr size_t O_WVP = O_WKP + (size_t)2048 * 1024;
constexpr size_t O_STP = O_WVP + (size_t)2048 * 1024;
constexpr size_t O_WKS = O_STP + 8 * 128 * 128;
constexpr size_t O_WVS = O_WKS + 32 * 1024;
constexpr size_t O_STS = O_WVS + 32 * 1024;

struct Params {
    const float* x_prompt; const float* x_sample; const float* cache_k; const float* cache_v; const float* state_in;
    const float* n_pre_mix; const float* w_in; const float* lb_logits; const float* attn_gain; const float* hg_gain;
    const float* w_out; const float* n_post_mix; const float* n_pre_ffn; const float* w_gate; const float* w_up;
    const float* w_down; const float* n_post_ffn;
    float* out; unsigned char* ws;
    int ph_lo, ph_hi;
};

typedef __bf16 bf16x2v_ __attribute__((ext_vector_type(2)));
typedef float f32x2v_ __attribute__((ext_vector_type(2)));
__device__ __forceinline__ unsigned pk2(float lo, float hi) { const f32x2v_ f = {lo, hi}; const bf16x2v_ b = __builtin_convertvector(f, bf16x2v_); return __builtin_bit_cast(unsigned, b); }
__device__ __forceinline__ bf16_t f2bf(float f) { unsigned u = __float_as_uint(f); u += 0x7FFFu + ((u >> 16) & 1u); return (bf16_t)(u >> 16); }
__device__ __forceinline__ float bf2f(bf16_t b) { return __uint_as_float(((unsigned)b) << 16); }
__device__ __forceinline__ float bflo(unsigned w) { return __uint_as_float(w << 16); }
__device__ __forceinline__ float bfhi(unsigned w) { return __uint_as_float(w & 0xffff0000u); }
__device__ __forceinline__ float wave_sum(float v) {
#pragma unroll
    for (int o = 1; o < 64; o <<= 1) v += __shfl_xor(v, o);
    return v;
}
__device__ __forceinline__ float sigmoidf_(float x) { return __builtin_amdgcn_rcpf(1.f + __expf(-x)); }
__device__ __forceinline__ float siluf_(float x) { return x * __builtin_amdgcn_rcpf(1.f + __expf(-x)); }

#define XB_TMO      128
#define XB_XCNT(j)  (256  + 64 * (j))
#define XB_XSUB(j)  (1280 + 64 * (j))
#define XB_XGEN(j)  (2304 + 64 * (j))
#define XB_TOP      3328
#define XB_TOPGEN   3392
#define XCD_BAR_WORDS 3456
#define XB_SPIN_CAP (1u << 18)
#define LAS __attribute__((address_space(3)))

__device__ __forceinline__ unsigned xb_ld(unsigned* p)              { return __hip_atomic_load(p, __ATOMIC_RELAXED, __HIP_MEMORY_SCOPE_AGENT); }
__device__ __forceinline__ unsigned xb_add(unsigned* p, unsigned v) { return __hip_atomic_fetch_add(p, v, __ATOMIC_RELAXED, __HIP_MEMORY_SCOPE_AGENT); }
__device__ __forceinline__ unsigned xb_xcc_id() { return (unsigned)__builtin_amdgcn_s_getreg((3 << 11) | 20) & 0xFu; }
#define XB_SPIN(cond, bar) do { unsigned _sp = 0; while (cond) { __builtin_amdgcn_s_sleep(1); \
    if ((++_sp & 255u) == 0u) { if (xb_ld(&(bar)[XB_TMO])) break; if (_sp > XB_SPIN_CAP) { atomicAdd(&(bar)[XB_TMO], 1u); break; } } } } while (0)

struct XcdBarrier {
    unsigned* bar; unsigned x;
    volatile LAS unsigned* st;
};

__device__ __forceinline__ XcdBarrier xcd_barrier_post(unsigned* bar, volatile LAS unsigned* st) {
    XcdBarrier b; b.bar = bar; b.x = xb_xcc_id(); b.st = st;
    if (threadIdx.x == 0) (void)xb_add(&bar[XB_XCNT(b.x)], 1u);
    return b;
}
__device__ __forceinline__ void xcd_barrier_complete(unsigned* bar, unsigned x, unsigned& nloc, unsigned& nx) {
    const unsigned G = gridDim.x * gridDim.y * gridDim.z;
    unsigned sum, cnt, mine, sp = 0u;
    for (;;) {
        sum = 0u; cnt = 0u; mine = 0u;
#pragma unroll
        for (unsigned j = 0; j < 16; ++j) { const unsigned c = xb_ld(&bar[XB_XCNT(j)]); sum += c; cnt += (c > 0u) ? 1u : 0u; mine = (j == x) ? c : mine; }
        if (sum == G) break;
        __builtin_amdgcn_s_sleep(1);
        if ((++sp & 255u) == 0u) { if (xb_ld(&bar[XB_TMO])) break; if (sp > XB_SPIN_CAP) { atomicAdd(&bar[XB_TMO], 1u); break; } }
    }
    nloc = mine > 0u ? mine : 1u; nx = cnt > 0u ? cnt : 1u;
}

__device__ __forceinline__ void xcd_barrier(const XcdBarrier& b) {
    asm volatile("s_waitcnt vmcnt(0)" ::: "memory");
    __syncthreads();
    if (threadIdx.x == 0) {
        unsigned* bar = b.bar;
        __builtin_amdgcn_s_waitcnt(0);
        unsigned nloc = b.st[0], nx = b.st[1];
        if (nloc == 0u) { xcd_barrier_complete(bar, b.x, nloc, nx); b.st[0] = nloc; b.st[1] = nx; }
        const unsigned old = xb_add(&bar[XB_XSUB(b.x)], 1u);
        const unsigned gen = old / nloc;
        if (old + 1u == (gen + 1u) * nloc) {
            __builtin_amdgcn_fence(__ATOMIC_RELEASE, "agent");
            asm volatile("s_waitcnt vmcnt(0)" ::: "memory");
            const unsigned og = xb_add(&bar[XB_TOP], 1u);
            const unsigned tg = og / nx;
            if (og + 1u == (tg + 1u) * nx) xb_add(&bar[XB_TOPGEN], 1u);
            else XB_SPIN(xb_ld(&bar[XB_TOPGEN]) == tg, bar);
            __builtin_amdgcn_fence(__ATOMIC_ACQUIRE, "agent");
            xb_add(&bar[XB_XGEN(b.x)], 1u);
            asm volatile("s_waitcnt vmcnt(0)" ::: "memory");
        } else {
            XB_SPIN(xb_ld(&bar[XB_XGEN(b.x)]) == gen, bar);
            __builtin_amdgcn_fence(__ATOMIC_ACQUIRE, "agent");
            asm volatile("s_waitcnt vmcnt(0)" ::: "memory");
        }
    }
    __syncthreads();
}

namespace pg8 {
#define PG8_LAS __attribute__((address_space(3)))
typedef unsigned short bf16_t;
typedef short bf16x8 __attribute__((ext_vector_type(8)));
typedef float f32x4 __attribute__((ext_vector_type(4)));
typedef unsigned u32x4 __attribute__((ext_vector_type(4)));
constexpr int BM = 256, BK = 64, HALF = 128, HTB = HALF * BK * 2  , STAGE_BYTES = 8 * HTB, NXCD = 8, WGM = 8;

__host__ __device__ __forceinline__ int lds_byte(int r, int c) { const int st = (r >> 4) * 2 + (c >> 5), rr = r & 15, cc = c & 31, ob = rr * 64 + cc * 2; return st * 1024 + (ob ^ (((ob >> 9) & 1) << 5)); }
__host__ __device__ __forceinline__ void stage_rc(int b, int& R, int& C) { const int st = b / 1024, sb = b % 1024, swz = sb ^ (((sb >> 9) & 1) << 5); R = (st >> 1) * 16 + swz / 64; C = (st & 1) * 32 + (swz % 64) / 2; }
__host__ __device__ __forceinline__ int perm32(int rho) { const int n = rho >> 4, i = rho & 15; return 8 * (i >> 2) + 4 * n + (i & 3); }

struct Unit { int pm, pn; };
struct Gemm { const bf16_t* A; const bf16_t* Bt; int M, N, K; };

struct StaticOrder {
    int nM, nN, nwg, G, c;
    __host__ __device__ void init(int M, int N, int G_, int c_) { nM = M / BM; nN = N / BM; nwg = nM * nN; G = G_; c = c_; }
    __host__ __device__ bool next(int i, Unit& u) const {
        const long L = (long)i * G + c; if (L >= nwg) return false;
        int wgid = (int)L; { const int q = nwg / NXCD, r = nwg % NXCD, xcd = wgid % NXCD, off = wgid / NXCD; wgid = (xcd < r ? xcd * (q + 1) : r * (q + 1) + (xcd - r) * q) + off; }
        const int nig = WGM * nN, gid = wgid / nig, fm = gid * WGM, gsz = (nM - fm) < WGM ? (nM - fm) : WGM;
        u.pm = fm + ((wgid % nig) % gsz); u.pn = (wgid % nig) / gsz; return true;
    }
    __device__ __forceinline__ void a_ready(const Unit&) const {}
    __device__ __forceinline__ void done(const Unit&) const {}
};
__device__ __forceinline__ unsigned cvt_pk_bf16(float lo, float hi) { unsigned r; asm volatile("v_cvt_pk_bf16_f32 %0, %1, %2" : "=v"(r) : "v"(lo), "v"(hi)); return r; }
template <class Epi, class Sched, bool STAMP = false>
__device__ __forceinline__ void gemm_phase(PG8_LAS unsigned char* lds, const Gemm g, const Sched& S, const Epi& E, unsigned long long* stamps) {
    const int tid = threadIdx.x, wid = __builtin_amdgcn_readfirstlane(tid >> 6), lane = tid & 63, wr = wid >> 2, wc = wid & 3, fr = lane & 15, fq = lane >> 4;
    const int K = g.K, nt = K / BK;
    int ts_lo = 0, ts_hi = 0, nts = 0; const unsigned long long rt_entry = STAMP ? (unsigned long long)wall_clock64() : 0ull;
#define PG8_STAMP() do { if (STAMP && wid == 0 && nts < 64) { const unsigned long long _c = (unsigned long long)clock64(); \
        ts_lo = (lane == nts) ? (int)(unsigned)_c : ts_lo; ts_hi = (lane == nts) ? (int)(unsigned)(_c >> 32) : ts_hi; ++nts; } } while (0)
    PG8_STAMP();
    unsigned voffA[2], voffB[2];
#pragma unroll
    for (int i = 0; i < 2; ++i) { int R, C; stage_rc(tid * 16 + i * 8192, R, C); const int Rb = Epi::PERM ? ((R & ~31) + perm32(R & 31)) : R;
        voffA[i] = (unsigned)(R * K + C) * 2u; voffB[i] = (unsigned)(Rb * K + C) * 2u; }
    const size_t kstep = (size_t)(BK * 2);
    const size_t hstep = (size_t)HALF * K * 2;
    const size_t tstep = 2 * hstep;
    const unsigned ldsw = (unsigned)wid * 1024u;
    const int aoff = lds_byte(wr * 64 + fr, fq * 8), boff = lds_byte(wc * 32 + fr, fq * 8);
#define PG8_SA(b, h) (((b) * 2 + (h)) * HTB)
#define PG8_SB(b, h) ((4 + (b) * 2 + (h)) * HTB)
#define PG8_STAGE(bufoff, gbase, voff) do { _Pragma("unroll") for (int _i = 0; _i < 2; ++_i) \
        __builtin_amdgcn_global_load_lds((const unsigned*)((const char*)(gbase) + (voff)[_i]), (PG8_LAS unsigned*)(lds + (bufoff) + ldsw + _i * 8192), 16, 0, 0); } while (0)
#define PG8_LDA(dst, b, h) do { _Pragma("unroll") for (int m = 0; m < 4; ++m) _Pragma("unroll") for (int k = 0; k < 2; ++k) dst[m][k] = *(const PG8_LAS bf16x8*)(lds + PG8_SA(b, h) + aoff + m * 2048 + k * 1024); } while (0)
#define PG8_LDB(dst, b, h) do { _Pragma("unroll") for (int n = 0; n < 2; ++n) _Pragma("unroll") for (int k = 0; k < 2; ++k) dst[n][k] = *(const PG8_LAS bf16x8*)(lds + PG8_SB(b, h) + boff + n * 2048 + k * 1024); } while (0)
#define PG8_MMA(ai, bj, At, Bt) do { __builtin_amdgcn_s_setprio(1); _Pragma("unroll") for (int m = 0; m < 4; ++m) _Pragma("unroll") for (int n = 0; n < 2; ++n) _Pragma("unroll") for (int k = 0; k < 2; ++k) \
        acc[ai][bj][m][n] = __builtin_amdgcn_mfma_f32_16x16x32_bf16(Bt[n][k], At[m][k], acc[ai][bj][m][n], 0, 0, 0); __builtin_amdgcn_s_setprio(0); } while (0)
#define PG8_WAIT_V(n) asm volatile("s_waitcnt vmcnt(" #n ")" ::: "memory")
#define PG8_WAIT_L(n) asm volatile("s_waitcnt lgkmcnt(" #n ")" ::: "memory")
#define PG8_BAR __builtin_amdgcn_s_barrier()
#define PG8_SCHED __builtin_amdgcn_sched_barrier(0)
    Unit cur, nxt; int ui = 0;
    if (!S.next(0, cur)) return;
    f32x4 acc[2][2][4][2];
#pragma unroll
    for (int a = 0; a < 2; ++a)
#pragma unroll
        for (int b = 0; b < 2; ++b)
#pragma unroll
            for (int m = 0; m < 4; ++m)
#pragma unroll
                for (int n = 0; n < 2; ++n) acc[a][b][m][n] = (f32x4){0.f, 0.f, 0.f, 0.f};
    bf16x8 At[4][2], B0[2][2], B1[2][2];
    const char* cA = (const char*)g.A + (size_t)cur.pm * tstep; const char* cB = (const char*)g.Bt + (size_t)cur.pn * tstep;
    S.a_ready(cur);
    PG8_STAGE(PG8_SB(0, 0), cB, voffB); PG8_STAGE(PG8_SA(0, 0), cA, voffA); PG8_STAGE(PG8_SB(0, 1), cB + hstep, voffB); PG8_STAGE(PG8_SA(0, 1), cA + hstep, voffA);
    if (wr == 1) PG8_BAR;
    PG8_WAIT_V(4); PG8_BAR;
    PG8_STAGE(PG8_SB(1, 0), cB + kstep, voffB); PG8_STAGE(PG8_SA(1, 0), cA + kstep, voffA); PG8_STAGE(PG8_SB(1, 1), cB + hstep + kstep, voffB);
    PG8_WAIT_V(6); PG8_BAR;
    PG8_STAMP();
    for (;;) {
        const bool has_next = S.next(ui + 1, nxt);
        const char* nA = has_next ? (const char*)g.A + (size_t)nxt.pm * tstep : cA; const char* nB = has_next ? (const char*)g.Bt + (size_t)nxt.pn * tstep : cB;
        for (int t = 0; t < nt; t += 2) {
            const bool last = (t == nt - 2);
            const char* a1 = cA + (size_t)(t + 1) * kstep;
            const char* a2 = last ? nA : cA + (size_t)(t + 2) * kstep; const char* b2 = last ? nB : cB + (size_t)(t + 2) * kstep;
            const char* a3 = a2 + kstep; const char* b3 = b2 + kstep;
            if (last && has_next) S.a_ready(nxt);
            PG8_LDB(B0, 0, 0); PG8_SCHED; PG8_LDA(At, 0, 0); PG8_STAGE(PG8_SA(1, 1), a1 + hstep, voffA);
            PG8_WAIT_L(8); PG8_BAR; PG8_WAIT_L(0); PG8_MMA(0, 0, At, B0); PG8_BAR; PG8_SCHED;
            PG8_LDB(B1, 0, 1); PG8_STAGE(PG8_SB(0, 0), b2, voffB);
            PG8_BAR; PG8_WAIT_L(0); PG8_MMA(0, 1, At, B1); PG8_BAR;
            PG8_LDA(At, 0, 1); PG8_STAGE(PG8_SA(0, 0), a2, voffA);
            PG8_BAR; PG8_WAIT_L(0); PG8_MMA(1, 0, At, B0); PG8_BAR; PG8_SCHED;
            PG8_STAGE(PG8_SB(0, 1), b2 + hstep, voffB);
            PG8_WAIT_V(6); PG8_BAR; PG8_MMA(1, 1, At, B1); PG8_BAR;
            PG8_LDB(B0, 1, 0); PG8_SCHED; PG8_LDA(At, 1, 0); PG8_STAGE(PG8_SA(0, 1), a2 + hstep, voffA);
            PG8_WAIT_L(8); PG8_BAR; PG8_WAIT_L(0); PG8_MMA(0, 0, At, B0); PG8_BAR; PG8_SCHED;
            PG8_LDB(B1, 1, 1); PG8_STAGE(PG8_SB(1, 0), b3, voffB);
            PG8_BAR; PG8_WAIT_L(0); PG8_MMA(0, 1, At, B1); PG8_BAR;
            PG8_LDA(At, 1, 1); PG8_STAGE(PG8_SA(1, 0), a3, voffA);
            PG8_BAR; PG8_WAIT_L(0); PG8_MMA(1, 0, At, B0); PG8_BAR; PG8_SCHED;
            PG8_STAGE(PG8_SB(1, 1), b3 + hstep, voffB);
            PG8_WAIT_V(6); PG8_BAR; PG8_MMA(1, 1, At, B1); PG8_BAR;
        }
        PG8_STAMP();
        if constexpr (!Epi::AFTER_DRAIN) { E(acc, cur, wr, wc, fr, fq); S.done(cur); }
        PG8_STAMP();
        if (!has_next) break;
#pragma unroll
        for (int a = 0; a < 2; ++a)
#pragma unroll
            for (int b = 0; b < 2; ++b)
#pragma unroll
                for (int m = 0; m < 4; ++m)
#pragma unroll
                    for (int n = 0; n < 2; ++n) acc[a][b][m][n] = (f32x4){0.f, 0.f, 0.f, 0.f};
        cur = nxt; cA = nA; cB = nB; ++ui;
    }
    PG8_WAIT_V(0);
    if (wr == 0) PG8_BAR;
    PG8_BAR;
    if constexpr (Epi::AFTER_DRAIN) { E.fused(acc, cur, wr, wc, fr, fq, lds, wid, lane); S.done(cur); }
    PG8_STAMP();
    if (STAMP && wid == 0) { stamps[lane] = lane < nts ? (((unsigned long long)(unsigned)ts_hi << 32) | (unsigned)ts_lo) : 0ull;
        if (lane == 62) stamps[62] = rt_entry; if (lane == 63) stamps[63] = (unsigned long long)wall_clock64(); }
#undef PG8_STAMP
#undef PG8_SA
#undef PG8_SB
#undef PG8_STAGE
#undef PG8_LDA
#undef PG8_LDB
#undef PG8_MMA
#undef PG8_WAIT_V
#undef PG8_WAIT_L
#undef PG8_BAR
#undef PG8_SCHED
}
}

using pg8::Unit;
struct EpiF32 {
    static constexpr bool PERM = false, AFTER_DRAIN = false;
    float* C; int ldc;
    __device__ __forceinline__ void operator()(const f32x4 (&acc)[2][2][4][2], const Unit& u, int wr, int wc, int fr, int fq) const {
        const int row0 = u.pm * 256 + wr * 64 + fr, col0 = u.pn * 256 + wc * 32 + 4 * fq;
#pragma unroll
        for (int ai = 0; ai < 2; ++ai)
#pragma unroll
            for (int m = 0; m < 4; ++m) { float* rowp = C + (size_t)(row0 + ai * 128 + m * 16) * ldc + col0;
#pragma unroll
                for (int bj = 0; bj < 2; ++bj)
#pragma unroll
                    for (int n = 0; n < 2; ++n) *(f32x4*)(rowp + bj * 128 + n * 16) = acc[ai][bj][m][n]; }
    }
};
struct EpiBf16P {
    static constexpr bool PERM = true, AFTER_DRAIN = false;
    bf16_t* O; int ldc;
    __device__ __forceinline__ void operator()(const f32x4 (&acc)[2][2][4][2], const Unit& u, int wr, int wc, int fr, int fq) const {
        const int row0 = u.pm * 256 + wr * 64 + fr, col0 = u.pn * 256 + wc * 32 + 8 * fq;
#pragma unroll
        for (int ai = 0; ai < 2; ++ai)
#pragma unroll
            for (int m = 0; m < 4; ++m) { bf16_t* rowp = O + (size_t)(row0 + ai * 128 + m * 16) * ldc + col0;
#pragma unroll
                for (int bj = 0; bj < 2; ++bj) { const f32x4 v0 = acc[ai][bj][m][0], v1 = acc[ai][bj][m][1];
                    u32x4 w; w.x = pk2(v0[0], v0[1]); w.y = pk2(v0[2], v0[3]); w.z = pk2(v1[0], v1[1]); w.w = pk2(v1[2], v1[3]);
                    *(u32x4*)(rowp + bj * 128) = w; } }
    }
};
struct EpiSwiGLU {
    static constexpr bool PERM = true, AFTER_DRAIN = false;
    bf16_t* FF;
    __device__ __forceinline__ void operator()(const f32x4 (&acc)[2][2][4][2], const Unit& u, int wr, int wc, int fr, int fq) const {
        const int row0 = u.pm * 256 + wr * 64 + fr, col0 = u.pn * 128 + wc * 32 + 8 * fq;
#pragma unroll
        for (int ai = 0; ai < 2; ++ai)
#pragma unroll
            for (int m = 0; m < 4; ++m) {
                const f32x4 g0 = acc[ai][0][m][0], g1 = acc[ai][0][m][1], u0 = acc[ai][1][m][0], u1 = acc[ai][1][m][1];
                u32x4 w;
                w.x = pk2(siluf_(g0[0]) * u0[0], siluf_(g0[1]) * u0[1]); w.y = pk2(siluf_(g0[2]) * u0[2], siluf_(g0[3]) * u0[3]);
                w.z = pk2(siluf_(g1[0]) * u1[0], siluf_(g1[1]) * u1[1]); w.w = pk2(siluf_(g1[2]) * u1[2], siluf_(g1[3]) * u1[3]);
                *(u32x4*)(FF + (size_t)(row0 + ai * 128 + m * 16) * DFF + col0) = w; }
    }
};
struct RotOrder : pg8::StaticOrder {
    __device__ __forceinline__ bool next(int i, Unit& u) const { if (!pg8::StaticOrder::next(i, u)) return false; u.pn = u.pn + 12; if (u.pn >= 28) u.pn -= 28; return true; }
};
struct EpiIn {
    static constexpr bool PERM = true, AFTER_DRAIN = false;
    bf16_t* QC; bf16_t* KC; bf16_t* VT; bf16_t* HG; float* outk; float* outv; float qscale;
    __device__ __forceinline__ void operator()(const f32x4 (&acc)[2][2][4][2], const Unit& u, int wr, int wc, int fr, int fq) const {
        const int region = u.pn >> 2;
        if (region == 2) {
#pragma unroll
            for (int ai = 0; ai < 2; ++ai)
#pragma unroll
                for (int bj = 0; bj < 2; ++bj) {
                    const int h = (u.pn & 3) * 2 + bj, d = wc * 32 + 8 * fq;
                    bf16_t* vb = VT + (((size_t)(h * 16 + fr) * 64 + u.pm) * 128 + d) * 16 + ai * 8 + wr * 4;
#pragma unroll
                    for (int n = 0; n < 2; ++n)
#pragma unroll
                        for (int j = 0; j < 4; ++j) { u32x2 w; w.x = pk2(acc[ai][bj][0][n][j], acc[ai][bj][1][n][j]); w.y = pk2(acc[ai][bj][2][n][j], acc[ai][bj][3][n][j]);
                            *(u32x2*)(vb + (4 * n + j) * 16) = w; }
#pragma unroll
                    for (int m = 0; m < 4; ++m) { const int t = u.pm * 256 + ai * 128 + wr * 64 + m * 16 + fr;
                        if (t >= T_ - 2048) { float* o = outv + (size_t)(t - (T_ - 2048)) * 1024 + h * 128 + d; *(f32x4*)o = acc[ai][bj][m][0]; *(f32x4*)(o + 4) = acc[ai][bj][m][1]; } }
                }
            return;
        }
#pragma unroll
        for (int ai = 0; ai < 2; ++ai)
#pragma unroll
            for (int m = 0; m < 4; ++m) {
                const int t = u.pm * 256 + ai * 128 + wr * 64 + m * 16 + fr;
#pragma unroll
                for (int bj = 0; bj < 2; ++bj) {
                    f32x4 v0 = acc[ai][bj][m][0], v1 = acc[ai][bj][m][1];
                    if (region >= 3) {
                        u32x4 w; w.x = pk2(v0[0], v0[1]); w.y = pk2(v0[2], v0[3]); w.z = pk2(v1[0], v1[1]); w.w = pk2(v1[2], v1[3]);
                        *(u32x4*)(HG + (size_t)t * 4096 + (u.pn - 12) * 256 + bj * 128 + wc * 32 + 8 * fq) = w;
                    } else {
                        const int h = (u.pn & 3) * 2 + bj, d = wc * 32 + 8 * fq, rho = t & 15, uu = t >> 4;
                        if (region == 0) {
                            v0 = v0 * qscale; v1 = v1 * qscale;
                            u32x4 w; w.x = pk2(v0[0], v0[1]); w.y = pk2(v0[2], v0[3]); w.z = pk2(v1[0], v1[1]); w.w = pk2(v1[2], v1[3]);
                            *(u32x4*)(QC + ((size_t)(h * 16 + rho) * 1024 + uu) * 128 + d) = w;
                        } else if (region == 1) {
                            u32x4 w; w.x = pk2(v0[0], v0[1]); w.y = pk2(v0[2], v0[3]); w.z = pk2(v1[0], v1[1]); w.w = pk2(v1[2], v1[3]);
                            *(u32x4*)(KC + ((((size_t)(h * 16 + rho) * 64 + (uu >> 4)) * 4 + wc) * 16 + (uu & 15)) * 32 + 8 * fq) = w;
                            if (t >= T_ - 2048) { float* o = outk + (size_t)(t - (T_ - 2048)) * 1024 + h * 128 + d; *(f32x4*)o = v0; *(f32x4*)(o + 4) = v1; }
                        } else {
                            bf16_t* vb = VT + (((size_t)(h * 16 + rho) * 64 + (uu >> 4)) * 128 + d) * 16 + (uu & 15);
#pragma unroll
                            for (int j = 0; j < 4; ++j) { vb[j * 16] = f2bf(v0[j]); vb[(4 + j) * 16] = f2bf(v1[j]); }
                            if (t >= T_ - 2048) { float* o = outv + (size_t)(t - (T_ - 2048)) * 1024 + h * 128 + d; *(f32x4*)o = v0; *(f32x4*)(o + 4) = v1; }
                        }
                    }
                }
            }
    }
};

#define WS_PTR(type, off) ((type*)(P.ws + (off)))
#define LDS_WAIT() asm volatile("s_waitcnt lgkmcnt(0)" ::: "memory")
#if MK_SETTLE
#define SETTLE() do { __builtin_amdgcn_sched_barrier(0); asm volatile("s_nop 15\n\ts_nop 15"); __builtin_amdgcn_sched_barrier(0); } while (0)
#else
#define SETTLE() do {} while (0)
#endif

__device__ __forceinline__ void transpose_item(const float* W, int K, int N, bf16_t* WT, int grp, int gstride, int goff, float* scr, int item, int lane) {
    const int nblk = N / 32, kb = item / nblk, nb = item % nblk, k0 = 64 * kb, n0 = 32 * nb;
    const int rowbase = (n0 / grp) * gstride + (n0 % grp) + goff;
    float wv[32];
#pragma unroll
    for (int i = 0; i < 32; ++i) wv[i] = __builtin_nontemporal_load(W + (size_t)(k0 + 2 * i + (lane >> 5)) * N + n0 + (lane & 31));
#pragma unroll
    for (int i = 0; i < 32; ++i) scr[(2 * i + (lane >> 5)) * 33 + (lane & 31)] = wv[i];
    LDS_WAIT();
    const int c = lane & 7;
#pragma unroll
    for (int j = 0; j < 4; ++j) { const int n = (lane >> 3) + 8 * j; const float* s = scr + (8 * c) * 33 + n;
        u32x4 o; o.x = pk2(s[0 * 33], s[1 * 33]); o.y = pk2(s[2 * 33], s[3 * 33]); o.z = pk2(s[4 * 33], s[5 * 33]); o.w = pk2(s[6 * 33], s[7 * 33]);
        *(u32x4*)(WT + (size_t)(rowbase + n) * K + k0 + 8 * c) = o; }
    LDS_WAIT();
}
__device__ __forceinline__ void rms_row_bf16(const float* x, const float* g, bf16_t* o, int lane) {
    f32x4 v[8]; float ss = 0.f;
#pragma unroll
    for (int j = 0; j < 8; ++j) { v[j] = ((const f32x4*)x)[lane + 64 * j]; ss += v[j][0] * v[j][0] + v[j][1] * v[j][1] + v[j][2] * v[j][2] + v[j][3] * v[j][3]; }
    const float r = rsqrtf(wave_sum(ss) * (1.f / 2048.f) + EPS_);
#pragma unroll
    for (int j = 0; j < 8; ++j) { const f32x4 gv = ((const f32x4*)g)[lane + 64 * j];
        u32x2 w; w.x = pk2(v[j][0] * r * gv[0], v[j][1] * r * gv[1]); w.y = pk2(v[j][2] * r * gv[2], v[j][3] * r * gv[3]);
        ((u32x2*)o)[lane + 64 * j] = w; }
}
__device__ __forceinline__ f32x4 ld4(const float* p, int i) { return ((const f32x4*)p)[i]; }
__device__ __forceinline__ f32x4 ld4(const bf16_t* p, int i) { const u32x2 w = ((const u32x2*)p)[i]; return (f32x4){bflo(w.x), bfhi(w.x), bflo(w.y), bfhi(w.y)}; }
__device__ __forceinline__ f32x4 ld4nt(const float* p, int i) { return __builtin_nontemporal_load((const f32x4*)p + i); }
__device__ __forceinline__ f32x4 ld4nt(const bf16_t* p, int i) { const u32x2 w = __builtin_nontemporal_load((const u32x2*)p + i); return (f32x4){bflo(w.x), bfhi(w.x), bflo(w.y), bfhi(w.y)}; }
__device__ __forceinline__ void st4nt(float* p, int i, f32x4 v) { __builtin_nontemporal_store(v, (f32x4*)p + i); }
__device__ __forceinline__ void st4(float* p, int i, f32x4 v) { ((f32x4*)p)[i] = v; }
__device__ __forceinline__ void st4(bf16_t* p, int i, f32x4 v) { u32x2 w; w.x = pk2(v[0], v[1]); w.y = pk2(v[2], v[3]); ((u32x2*)p)[i] = w; }
template <class TM, class TX> __device__ __forceinline__ void post_mix_row(const float* x, const TM* mix, const float* g1, const float* g2, TX* x1out, bf16_t* h2, int lane) {
    f32x4 v[8]; float ss = 0.f;
#pragma unroll
    for (int j = 0; j < 8; ++j) { v[j] = ld4(mix, lane + 64 * j); ss += v[j][0] * v[j][0] + v[j][1] * v[j][1] + v[j][2] * v[j][2] + v[j][3] * v[j][3]; }
    const float r = rsqrtf(wave_sum(ss) * (1.f / 2048.f) + EPS_);
    float ss2 = 0.f;
#pragma unroll
    for (int j = 0; j < 8; ++j) { const f32x4 gv = ((const f32x4*)g1)[lane + 64 * j]; const f32x4 xv = ((const f32x4*)x)[lane + 64 * j];
        v[j] = xv + v[j] * r * gv; st4(x1out, lane + 64 * j, v[j]);
        ss2 += v[j][0] * v[j][0] + v[j][1] * v[j][1] + v[j][2] * v[j][2] + v[j][3] * v[j][3]; }
    const float r2 = rsqrtf(wave_sum(ss2) * (1.f / 2048.f) + EPS_);
#pragma unroll
    for (int j = 0; j < 8; ++j) { const f32x4 gv = ((const f32x4*)g2)[lane + 64 * j];
        u32x2 w; w.x = pk2(v[j][0] * r2 * gv[0], v[j][1] * r2 * gv[1]); w.y = pk2(v[j][2] * r2 * gv[2], v[j][3] * r2 * gv[3]);
        ((u32x2*)h2)[lane + 64 * j] = w; }
}
template <class TM, class TX> __device__ __forceinline__ void final_row(const TX* x1, const TM* ffo, const float* g, float* y, int lane) {
    f32x4 v[8]; float ss = 0.f;
#pragma unroll
    for (int j = 0; j < 8; ++j) { v[j] = ld4(ffo, lane + 64 * j); ss += v[j][0] * v[j][0] + v[j][1] * v[j][1] + v[j][2] * v[j][2] + v[j][3] * v[j][3]; }
    const float r = rsqrtf(wave_sum(ss) * (1.f / 2048.f) + EPS_);
#pragma unroll
    for (int j = 0; j < 8; ++j) { const f32x4 gv = ((const f32x4*)g)[lane + 64 * j]; const f32x4 xv = ld4(x1, lane + 64 * j);
        ((f32x4*)y)[lane + 64 * j] = xv + v[j] * r * gv; }
}

__device__ __forceinline__ float sq4(f32x4 v) { return v[0] * v[0] + v[1] * v[1] + v[2] * v[2] + v[3] * v[3]; }
__device__ __forceinline__ void rms_row2_bf16(const float* x, const float* g, bf16_t* o, size_t d2, int lane) {
    f32x4 v[2][8]; float ss[2] = {0.f, 0.f};
#pragma unroll
    for (int rr = 0; rr < 2; ++rr)
#pragma unroll
        for (int j = 0; j < 8; ++j) v[rr][j] = ld4nt(x + rr * d2, lane + 64 * j);
#pragma unroll
    for (int rr = 0; rr < 2; ++rr)
#pragma unroll
        for (int j = 0; j < 8; ++j) ss[rr] += sq4(v[rr][j]);
    const float r0 = rsqrtf(wave_sum(ss[0]) * (1.f / 2048.f) + EPS_), r1 = rsqrtf(wave_sum(ss[1]) * (1.f / 2048.f) + EPS_);
#pragma unroll
    for (int j = 0; j < 8; ++j) { const f32x4 gv = ((const f32x4*)g)[lane + 64 * j];
        st4(o, lane + 64 * j, v[0][j] * r0 * gv); st4(o + d2, lane + 64 * j, v[1][j] * r1 * gv); }
}
template <class TM, class TX> __device__ __forceinline__ void post_mix_row2(const float* x, const TM* mix, const float* g1, const float* g2, TX* x1out, bf16_t* h2, size_t d2, int lane) {
    f32x4 v[2][8], xv[2][8]; float ss[2] = {0.f, 0.f};
#pragma unroll
    for (int rr = 0; rr < 2; ++rr)
#pragma unroll
        for (int j = 0; j < 8; ++j) { v[rr][j] = ld4nt(mix + rr * d2, lane + 64 * j); xv[rr][j] = ld4nt(x + rr * d2, lane + 64 * j); }
#pragma unroll
    for (int rr = 0; rr < 2; ++rr)
#pragma unroll
        for (int j = 0; j < 8; ++j) ss[rr] += sq4(v[rr][j]);
    const float r0 = rsqrtf(wave_sum(ss[0]) * (1.f / 2048.f) + EPS_), r1 = rsqrtf(wave_sum(ss[1]) * (1.f / 2048.f) + EPS_);
    float s2[2] = {0.f, 0.f};
#pragma unroll
    for (int j = 0; j < 8; ++j) { const f32x4 gv = ((const f32x4*)g1)[lane + 64 * j];
        v[0][j] = xv[0][j] + v[0][j] * r0 * gv; v[1][j] = xv[1][j] + v[1][j] * r1 * gv;
        st4(x1out, lane + 64 * j, v[0][j]); st4(x1out + d2, lane + 64 * j, v[1][j]);
        s2[0] += sq4(v[0][j]); s2[1] += sq4(v[1][j]); }
    const float q0 = rsqrtf(wave_sum(s2[0]) * (1.f / 2048.f) + EPS_), q1 = rsqrtf(wave_sum(s2[1]) * (1.f / 2048.f) + EPS_);
#pragma unroll
    for (int j = 0; j < 8; ++j) { const f32x4 gv = ((const f32x4*)g2)[lane + 64 * j];
        st4(h2, lane + 64 * j, v[0][j] * q0 * gv); st4(h2 + d2, lane + 64 * j, v[1][j] * q1 * gv); }
}
template <class TM, class TX> __device__ __forceinline__ void final_row2(const TX* x1, const TM* ffo, const float* g, float* y, size_t d2, int lane) {
    f32x4 v[2][8], xv[2][8]; float ss[2] = {0.f, 0.f};
#pragma unroll
    for (int rr = 0; rr < 2; ++rr)
#pragma unroll
        for (int j = 0; j < 8; ++j) { v[rr][j] = ld4nt(ffo + rr * d2, lane + 64 * j); xv[rr][j] = ld4nt(x1 + rr * d2, lane + 64 * j); }
#pragma unroll
    for (int rr = 0; rr < 2; ++rr)
#pragma unroll
        for (int j = 0; j < 8; ++j) ss[rr] += sq4(v[rr][j]);
    const float r0 = rsqrtf(wave_sum(ss[0]) * (1.f / 2048.f) + EPS_), r1 = rsqrtf(wave_sum(ss[1]) * (1.f / 2048.f) + EPS_);
#pragma unroll
    for (int j = 0; j < 8; ++j) { const f32x4 gv = ((const f32x4*)g)[lane + 64 * j];
        st4nt(y, lane + 64 * j, xv[0][j] + v[0][j] * r0 * gv); st4nt(y + d2, lane + 64 * j, xv[1][j] + v[1][j] * r1 * gv); }
}

template <class F> __device__ __forceinline__ void skinny_gemm(const bf16_t* A, const bf16_t* Bt, int K, int N, float* red, F store, int i0 = -1, int istep = 0) {
    const int tid = threadIdx.x, wave = tid >> 6, lane = tid & 63, r16 = lane & 15, g = lane >> 4;
    if (i0 < 0) { i0 = blockIdx.x; istep = gridDim.x; }
    for (int item = i0; item < N / 16; item += istep) {
        const int n0 = item * 16, kper = K >> 3, kb = wave * kper;
        const bf16_t* a0p = A + (size_t)r16 * K + kb + g * 8; const bf16_t* a1p = a0p + (size_t)16 * K;
        const bf16_t* bp = Bt + (size_t)(n0 + r16) * K + kb + g * 8;
        f32x4 c0 = {0.f, 0.f, 0.f, 0.f}, c1 = {0.f, 0.f, 0.f, 0.f};
#pragma unroll 8
        for (int k = 0; k < kper; k += 32) {
            const s16x8 a0 = *(const s16x8*)(a0p + k), a1 = *(const s16x8*)(a1p + k), b = *(const s16x8*)(bp + k);
            c0 = __builtin_amdgcn_mfma_f32_16x16x32_bf16(a0, b, c0, 0, 0, 0); c1 = __builtin_amdgcn_mfma_f32_16x16x32_bf16(a1, b, c1, 0, 0, 0);
            asm volatile("" : "+v"(c0), "+v"(c1) : "v"(a0), "v"(a1), "v"(b)); }
#pragma unroll
        for (int j = 0; j < 4; ++j) { red[wave * 512 + (g * 4 + j) * 16 + r16] = c0[j]; red[wave * 512 + (16 + g * 4 + j) * 16 + r16] = c1[j]; }
        __syncthreads();
        float s = 0.f;
#pragma unroll
        for (int w = 0; w < 8; ++w) s += red[w * 512 + tid];
        store(tid >> 4, n0 + (tid & 15), s);
        __syncthreads();
    }
}
__device__ __forceinline__ void skinny_gu(const bf16_t* A, const bf16_t* Bt, bf16_t* ffs, float* red) {
    const int tid = threadIdx.x, wave = tid >> 6, lane = tid & 63, r16 = lane & 15, g = lane >> 4;
    constexpr int K = 2048;
    for (int item = blockIdx.x; item < DFF / 16; item += gridDim.x) {
        const int n0 = item * 16, kper = K >> 3, kb = wave * kper;
        const int rowg = (n0 / 128) * 256 + (n0 % 128) + r16;
        const bf16_t* a0p = A + (size_t)r16 * K + kb + g * 8; const bf16_t* a1p = a0p + (size_t)16 * K;
        const bf16_t* bgp = Bt + (size_t)rowg * K + kb + g * 8; const bf16_t* bup = bgp + (size_t)128 * K;
        f32x4 c0 = {0.f, 0.f, 0.f, 0.f}, c1 = c0, c2 = c0, c3 = c0;
#pragma unroll 8
        for (int k = 0; k < kper; k += 32) {
            const s16x8 a0 = *(const s16x8*)(a0p + k), a1 = *(const s16x8*)(a1p + k), bg = *(const s16x8*)(bgp + k), bu = *(const s16x8*)(bup + k);
            c0 = __builtin_amdgcn_mfma_f32_16x16x32_bf16(a0, bg, c0, 0, 0, 0); c1 = __builtin_amdgcn_mfma_f32_16x16x32_bf16(a1, bg, c1, 0, 0, 0);
            c2 = __builtin_amdgcn_mfma_f32_16x16x32_bf16(a0, bu, c2, 0, 0, 0); c3 = __builtin_amdgcn_mfma_f32_16x16x32_bf16(a1, bu, c3, 0, 0, 0);
            asm volatile("" : "+v"(c0), "+v"(c1), "+v"(c2), "+v"(c3) : "v"(a0), "v"(a1), "v"(bg), "v"(bu)); }
#pragma unroll
        for (int j = 0; j < 4; ++j) { red[wave * 1024 + (g * 4 + j) * 16 + r16] = c0[j]; red[wave * 1024 + (16 + g * 4 + j) * 16 + r16] = c1[j];
            red[wave * 1024 + 512 + (g * 4 + j) * 16 + r16] = c2[j]; red[wave * 1024 + 512 + (16 + g * 4 + j) * 16 + r16] = c3[j]; }
        __syncthreads();
        float sg = 0.f, su = 0.f;
#pragma unroll
        for (int w = 0; w < 8; ++w) { sg += red[w * 1024 + tid]; su += red[w * 1024 + 512 + tid]; }
        ffs[(size_t)(tid >> 4) * DFF + n0 + (tid & 15)] = f2bf(siluf_(sg) * su);
        __syncthreads();
    }
}

__device__ __forceinline__ int att_tile0(int r, int rho, int q0) {
    const int delta = r - rho;
    const int hmax = (delta == 0) ? 128 : (((delta & 3) == 0) ? ((512 - delta) >> 4) : ((128 - delta) >> 4));
    const int t0 = (q0 - hmax) >> 4; return t0 < 0 ? 0 : t0;
}
__device__ __forceinline__ void attn_item(const Params& P, int item_, int lane) {
    const int item = __builtin_amdgcn_readfirstlane(item_);
    const int r = item & 15, pm = (item >> 4) & 63, h = item >> 10;
    const int q0 = pm * 16, g = lane >> 4, r16 = lane & 15;
    const bf16_t* QC = WS_PTR(const bf16_t, WS_QC);
    const char* KCu = (const char*)(WS_PTR(const bf16_t, WS_KC) + (size_t)h * 16 * 1024 * 128);
    const char* VTu = (const char*)(WS_PTR(const bf16_t, WS_VT) + (size_t)h * 16 * 128 * 1024);
    const unsigned klane = (unsigned)(r16 * 64 + g * 16), vlane = (unsigned)(r16 * 32 + g * 8);
    s16x8 qf[4];
    { const bf16_t* qb = QC + ((size_t)(h * 16 + r) * 1024 + q0 + r16) * 128 + g * 8;
#pragma unroll
      for (int kk = 0; kk < 4; ++kk) qf[kk] = *(const s16x8*)(qb + 32 * kk); }
    float m_run = -INFINITY, l_run = 0.f;
    f32x4 o[8];
#pragma unroll
    for (int dt = 0; dt < 8; ++dt) o[dt] = (f32x4){0.f, 0.f, 0.f, 0.f};
    int NT = 0;
    for (int rho = 0; rho < 16; ++rho) NT += pm - att_tile0(r, rho, q0) + 1;
#define ATT_LOAD(KF, VF, rho_, tile_) do { \
        const char* kp_ = KCu + (size_t)(((rho_) * 64 + (tile_)) * 4096) + klane; \
        _Pragma("unroll") for (int kk = 0; kk < 4; ++kk) KF[kk] = *(const s16x8*)(kp_ + 1024 * kk); \
        const char* vp_ = VTu + (size_t)(((rho_) * 64 + (tile_)) * 4096) + vlane; \
        _Pragma("unroll") for (int dt = 0; dt < 8; ++dt) VF[dt] = *(const s16x4*)(vp_ + 512 * dt); } while (0)
#define ATT_NEXT(rho_, tile_) do { if (++tile_ > pm) { if (rho_ < 15) { ++rho_; tile_ = att_tile0(r, rho_, q0); } else tile_ = pm; } } while (0)
#define ATT_COMPUTE(KF, VF, rho_, tile_, valid_) do { \
        const int delta = r - (rho_); const int lo = delta < 0 ? 1 : 0; const int h1 = (128 - delta) >> 4; \
        const int h2 = ((delta & 3) == 0) ? ((512 - delta) >> 4) : -1; const int h3 = (delta == 0) ? 128 : -1; \
        f32x4 s = {0.f, 0.f, 0.f, 0.f}; \
        _Pragma("unroll") for (int kk = 0; kk < 4; ++kk) s = __builtin_amdgcn_mfma_f32_16x16x32_bf16(KF[kk], qf[kk], s, 0, 0, 0); \
        asm volatile("" : "+v"(s) : "v"(KF[0]), "v"(KF[1]), "v"(KF[2]), "v"(KF[3])); \
        const int dist = (q0 + r16) - ((tile_) * 16 + 4 * g); \
        const int lo_ = (valid_) ? lo : (1 << 20); \
        float mult[4], sv[4]; float tm = -INFINITY; \
        _Pragma("unroll") for (int i = 0; i < 4; ++i) { const int dd = dist - i; \
            int mu = (int)(dd <= h1) + (int)(dd <= h2) + (int)(dd <= h3); mu = (dd >= lo_) ? mu : 0; \
            mult[i] = (float)mu; sv[i] = (mu > 0) ? s[i] : -INFINITY; tm = fmaxf(tm, sv[i]); } \
        tm = fmaxf(tm, __shfl_xor(tm, 16)); tm = fmaxf(tm, __shfl_xor(tm, 32)); \
        const float m_new = fmaxf(m_run, tm); \
        if (__any(m_new > m_run)) { \
            const float alpha = (m_new == -INFINITY) ? 1.f : __builtin_amdgcn_exp2f(m_run - m_new); \
            l_run *= alpha; \
            _Pragma("unroll") for (int dt = 0; dt < 8; ++dt) o[dt] = o[dt] * alpha; \
            m_run = m_new; } \
        float p[4]; const float m_use = fmaxf(m_run, -1e30f); \
        _Pragma("unroll") for (int i = 0; i < 4; ++i) { p[i] = mult[i] * __builtin_amdgcn_exp2f(sv[i] - m_use); l_run += p[i]; } \
        u32x2 pw; pw.x = pk2(p[0], p[1]); pw.y = pk2(p[2], p[3]); \
        const s16x4 pb = __builtin_bit_cast(s16x4, pw); \
        _Pragma("unroll") for (int dt = 0; dt < 8; ++dt) o[dt] = __builtin_amdgcn_mfma_f32_16x16x16bf16_1k(VF[dt], pb, o[dt], 0, 0, 0); \
        asm volatile("" : "+v"(o[0]), "+v"(o[7]) : "v"(pb), "v"(VF[0]), "v"(VF[1]), "v"(VF[2]), "v"(VF[3]), "v"(VF[4]), "v"(VF[5]), "v"(VF[6]), "v"(VF[7])); } while (0)
    int prho = 0, ptile = att_tile0(r, 0, q0), crho = 0, ctile = ptile;
    s16x8 kfA[4], kfB[4], kfC[4]; s16x4 vfA[8], vfB[8], vfC[8];
    ATT_LOAD(kfA, vfA, prho, ptile); ATT_NEXT(prho, ptile);
    ATT_LOAD(kfB, vfB, prho, ptile); ATT_NEXT(prho, ptile);
    for (int step = 0; step < NT; step += 3) {
        ATT_LOAD(kfC, vfC, prho, ptile); ATT_NEXT(prho, ptile);
        ATT_COMPUTE(kfA, vfA, crho, ctile, true); ATT_NEXT(crho, ctile);
        ATT_LOAD(kfA, vfA, prho, ptile); ATT_NEXT(prho, ptile);
        ATT_COMPUTE(kfB, vfB, crho, ctile, (step + 1 < NT)); ATT_NEXT(crho, ctile);
        ATT_LOAD(kfB, vfB, prho, ptile); ATT_NEXT(prho, ptile);
        ATT_COMPUTE(kfC, vfC, crho, ctile, (step + 2 < NT)); ATT_NEXT(crho, ctile);
    }
#undef ATT_LOAD
#undef ATT_NEXT
#undef ATT_COMPUTE
    float l = l_run; l += __shfl_xor(l, 16); l += __shfl_xor(l, 32);
    const float inv = 1.f / l;
    const int t = 16 * (q0 + r16) + r;
    bf16_t* op = WS_PTR(bf16_t, WS_OATT) + (size_t)t * 1024 + h * 128 + 4 * g;
#pragma unroll
    for (int dt = 0; dt < 8; ++dt) { const f32x4 v = o[dt] * inv;
        u32x2 w; w.x = pk2(v[0], v[1]); w.y = pk2(v[2], v[3]); *(u32x2*)(op + 16 * dt) = w; }
}

__device__ __forceinline__ int samp_dist(int slot) { return slot < 129 ? slot : (slot < 258 ? 4 * (slot - 129) : 16 * (slot - 258)); }
__device__ __forceinline__ void sattn_item(const Params& P, int item, float* lf) {
    const int tid = threadIdx.x, wave = tid >> 6, b = item >> 3, h = item & 7;
    float* qs = lf; float* sc = lf + 128; float* red = lf + 640; float* po = lf + 704;
    const float* proj = WS_PTR(const float, WS_PROJS) + (size_t)b * NIN;
    if (tid < 128) { qs[tid] = proj[h * 128 + tid] * 0.08838834764831845f;
        P.out[O_WKS + b * 1024 + h * 128 + tid] = proj[1024 + h * 128 + tid]; P.out[O_WVS + b * 1024 + h * 128 + tid] = proj[2048 + h * 128 + tid]; }
    __syncthreads();
    const bool valid = tid < 387; const int d = samp_dist(tid);
    float s = -INFINITY;
    if (valid) { const float* kp = (d == 0) ? (proj + 1024 + h * 128) : (P.cache_k + (((size_t)b * PAST + (PAST - d)) * 8 + h) * 128);
        float a = 0.f;
#pragma unroll 16
        for (int j = 0; j < 32; ++j) { const f32x4 kv = ((const f32x4*)kp)[j]; const f32x4 qv = ((const f32x4*)qs)[j]; a += kv[0] * qv[0] + kv[1] * qv[1] + kv[2] * qv[2] + kv[3] * qv[3]; }
        s = a; }
    float m = s;
#pragma unroll
    for (int o = 1; o < 64; o <<= 1) m = fmaxf(m, __shfl_xor(m, o));
    if ((tid & 63) == 0) red[wave] = m;
    __syncthreads();
    m = red[0];
#pragma unroll
    for (int w = 1; w < 8; ++w) m = fmaxf(m, red[w]);
    const float p = valid ? __expf(s - m) : 0.f;
    sc[tid] = p;
    const float ps = wave_sum(p);
    __syncthreads();
    if ((tid & 63) == 0) red[8 + wave] = ps;
    __syncthreads();
    float tot = 0.f;
#pragma unroll
    for (int w = 0; w < 8; ++w) tot += red[8 + w];
    const int dq = tid & 31, kg = tid >> 5; f32x4 acc = {0.f, 0.f, 0.f, 0.f};
#pragma unroll
    for (int it = 0; it < 25; ++it) { const int j = kg + 16 * it;
        if (j < 387) { const int dj = samp_dist(j);
            const float* vp = (dj == 0) ? (proj + 2048 + h * 128) : (P.cache_v + (((size_t)b * PAST + (PAST - dj)) * 8 + h) * 128);
            const f32x4 vv = ((const f32x4*)vp)[dq]; const float pj = sc[j]; acc = acc + vv * pj; } }
    __syncthreads();
    ((f32x4*)po)[kg * 32 + dq] = acc;
    __syncthreads();
    if (tid < 128) { float o = 0.f;
#pragma unroll
        for (int q = 0; q < 16; ++q) o += po[q * 128 + tid];
        WS_PTR(float, WS_OATTS)[b * 1024 + h * 128 + tid] = o / tot; }
    __syncthreads();
}
__device__ __forceinline__ void shgrn_item(const Params& P, int item, float* lf) {
    const int tid = threadIdx.x, wave = tid >> 6, b = item >> 3, h = item & 7;
    float* qv = lf; float* fv = lf + 128; float* kv = lf + 256; float* po = lf + 384; float* red = lf + 896;
    const float* proj = WS_PTR(const float, WS_PROJS) + (size_t)b * NIN;
    if (tid < 128) { const int idx = h * 128 + tid; const float l0 = P.lb_logits[idx], l1 = P.lb_logits[1024 + idx];
        const float lbv = 1.f / (1.f + __expf(l1 - l0)); const float x = proj[4096 + idx];
        fv[tid] = lbv + (1.f - lbv) * sigmoidf_(x); kv[tid] = (1.f - lbv) * sigmoidf_(-x); qv[tid] = siluf_(proj[3072 + idx]); }
    __syncthreads();
    const int v = tid & 127, grp = tid >> 7; const float vv = proj[5120 + h * 128 + v]; float acc = 0.f;
    const size_t sb = ((size_t)(b * 8 + h) * 128) * 128;
#pragma unroll 16
    for (int k = grp * 32; k < grp * 32 + 32; ++k) { const float s = fv[k] * __builtin_nontemporal_load(P.state_in + sb + (size_t)k * 128 + v) + kv[k] * vv; __builtin_nontemporal_store(s, P.out + O_STS + sb + (size_t)k * 128 + v); acc += qv[k] * s; }
    po[tid] = acc;
    __syncthreads();
    float o = 0.f;
    if (tid < 128) { o = po[tid] + po[tid + 128] + po[tid + 256] + po[tid + 384]; const float ss = wave_sum(o * o); if ((tid & 63) == 0) red[wave] = ss; }
    __syncthreads();
    if (tid < 128) { const float rstd = rsqrtf((red[0] + red[1]) * (1.f / 128.f) + EPS_);
        WS_PTR(float, WS_OHGS)[b * 1024 + h * 128 + tid] = o * rstd * P.hg_gain[tid] * siluf_(proj[6144 + h * 128 + tid]); }
    __syncthreads();
}

template <bool OUT> __device__ __forceinline__ void hgrn_item(const Params& P, int item, unsigned char* lds) {
    const int tid = threadIdx.x, wave = tid >> 6, lane = tid & 63, g = lane >> 4, r16 = lane & 15;
    const int h = item / NCH, c = item % NCH;
    bf16_t* Qs = (bf16_t*)lds; bf16_t* Ks = (bf16_t*)(lds + 17408); bf16_t* KHt = (bf16_t*)(lds + 34816); bf16_t* Vt = (bf16_t*)(lds + 51200);
    float* Ds = (float*)(lds + 67584); float* Os = (float*)(lds + 69632);
    const bf16_t* HG = WS_PTR(const bf16_t, WS_HG);
    f32x4 S[8];
    float* Ub = WS_PTR(float, WS_U) + ((size_t)(c * 8 + h) * 128) * 128 + 16 * wave + r16;
#pragma unroll
    for (int kt = 0; kt < 8; ++kt) {
        if (OUT && MK_VAR != 1) {
#pragma unroll
            for (int i = 0; i < 4; ++i) S[kt][i] = Ub[(size_t)(16 * kt + 4 * g + i) * 128];
        } else S[kt] = (f32x4){0.f, 0.f, 0.f, 0.f};
    }
    float dtot = 1.f;
    unsigned short fx[16], vx[16], qx[16];
#define HG_LOADS(t0_) do { const bf16_t* hg_ = HG + (size_t)((t0_) + (tid >> 7) * 16) * 4096 + h * 128 + (tid & 127); \
        _Pragma("unroll") for (int t = 0; t < 16; ++t) { \
            if (OUT) { fx[t] = __builtin_nontemporal_load(hg_ + (size_t)t * 4096 + 1024); vx[t] = __builtin_nontemporal_load(hg_ + (size_t)t * 4096 + 2048); qx[t] = __builtin_nontemporal_load(hg_ + (size_t)t * 4096); } \
            else { fx[t] = hg_[(size_t)t * 4096 + 1024]; vx[t] = hg_[(size_t)t * 4096 + 2048]; } } } while (0)
    HG_LOADS(c * 256);
    f32x4 gnv[4];
    if (OUT) {
#pragma unroll
        for (int q = 0; q < 4; ++q) gnv[q] = ((const f32x4*)(P.hg_gain + 16 * (tid & 7)))[q]; }
    for (int sc = 0; sc < 4; ++sc) {
    const int t0 = c * 256 + sc * 64;
    u32x4 ga = {0u, 0u, 0u, 0u}, gb = ga;
    if (OUT) { const u32x4* gp = (const u32x4*)(HG + (size_t)(t0 + (tid >> 3)) * 4096 + 3072 + h * 128 + 16 * (tid & 7)); ga = gp[0]; gb = gp[1]; }
    {
        const int k = tid & 127, sb = tid >> 7;
        const float l0 = P.lb_logits[h * 128 + k], l1 = P.lb_logits[1024 + h * 128 + k];
        const float lbk = __builtin_amdgcn_rcpf(1.f + __expf(l1 - l0));
        float fv_[16], kvv[16], Pt[16]; float run = 1.f;
#pragma unroll
        for (int t = 0; t < 16; ++t) { const float x = bf2f(fx[t]); const float sg = __builtin_amdgcn_rcpf(1.f + __expf(-x));
            fv_[t] = lbk + (1.f - lbk) * sg; kvv[t] = (1.f - lbk) * (1.f - sg); run *= fv_[t]; Pt[t] = run; }
        float khat[16]; float sfx = 1.f;
#pragma unroll
        for (int t = 15; t >= 0; --t) { khat[t] = kvv[t] * sfx; sfx *= fv_[t]; }
        unsigned khp[8], vtp[8];
#pragma unroll
        for (int t = 0; t < 16; t += 2) {
            if (OUT) {
                const float qa = siluf_(bf2f(qx[t])), qb = siluf_(bf2f(qx[t + 1]));
                Qs[(sb * 16 + t) * 136 + k] = f2bf(qa * Pt[t]); Qs[(sb * 16 + t + 1) * 136 + k] = f2bf(qb * Pt[t + 1]);
                Ks[(sb * 16 + t) * 136 + k] = f2bf(kvv[t] * __builtin_amdgcn_rcpf(Pt[t])); Ks[(sb * 16 + t + 1) * 136 + k] = f2bf(kvv[t + 1] * __builtin_amdgcn_rcpf(Pt[t + 1]));
            }
            khp[t >> 1] = pk2(khat[t], khat[t + 1]);
            vtp[t >> 1] = (unsigned)vx[t] | ((unsigned)vx[t + 1] << 16);
        }
        u32x4* kd = (u32x4*)(KHt + (sb * 128 + k) * 16); kd[0] = (u32x4){khp[0], khp[1], khp[2], khp[3]}; kd[1] = (u32x4){khp[4], khp[5], khp[6], khp[7]};
        u32x4* vd = (u32x4*)(Vt + (sb * 128 + k) * 16); vd[0] = (u32x4){vtp[0], vtp[1], vtp[2], vtp[3]}; vd[1] = (u32x4){vtp[4], vtp[5], vtp[6], vtp[7]};
        Ds[sb * 128 + k] = run;
    }
    __syncthreads();
    if (sc < 3) HG_LOADS(t0 + 64);
    float gg[16];
    if (OUT) {
        const unsigned gw[8] = {ga.x, ga.y, ga.z, ga.w, gb.x, gb.y, gb.z, gb.w};
#pragma unroll
        for (int q = 0; q < 4; ++q) { const f32x4 gn = gnv[q];
            gg[4 * q] = gn[0] * siluf_(bflo(gw[2 * q])); gg[4 * q + 1] = gn[1] * siluf_(bfhi(gw[2 * q]));
            gg[4 * q + 2] = gn[2] * siluf_(bflo(gw[2 * q + 1])); gg[4 * q + 3] = gn[3] * siluf_(bfhi(gw[2 * q + 1])); } }
    for (int sb = 0; sb < 4; ++sb) {
        const s16x4 vA = *(const s16x4*)(Vt + (sb * 128 + 16 * wave + r16) * 16 + 4 * g);
        if (OUT) {
            s16x8 qB[4], kA[4];
#pragma unroll
            for (int kk = 0; kk < 4; ++kk) {
                const s16x4 ql = *(const s16x4*)(Qs + (sb * 16 + r16) * 136 + 32 * kk + 4 * g), qh = *(const s16x4*)(Qs + (sb * 16 + r16) * 136 + 32 * kk + 16 + 4 * g);
                qB[kk] = __builtin_shufflevector(ql, qh, 0, 1, 2, 3, 4, 5, 6, 7);
                const s16x4 kl = *(const s16x4*)(Ks + (sb * 16 + r16) * 136 + 32 * kk + 4 * g), kh = *(const s16x4*)(Ks + (sb * 16 + r16) * 136 + 32 * kk + 16 + 4 * g);
                kA[kk] = __builtin_shufflevector(kl, kh, 0, 1, 2, 3, 4, 5, 6, 7);
            }
            f32x4 oT = {0.f, 0.f, 0.f, 0.f}, aT = {0.f, 0.f, 0.f, 0.f};
#pragma unroll
            for (int kk = 0; kk < 4; ++kk) {
                u32x4 sw; sw.x = pk2(S[2 * kk][0], S[2 * kk][1]); sw.y = pk2(S[2 * kk][2], S[2 * kk][3]); sw.z = pk2(S[2 * kk + 1][0], S[2 * kk + 1][1]); sw.w = pk2(S[2 * kk + 1][2], S[2 * kk + 1][3]);
                const s16x8 sA = __builtin_bit_cast(s16x8, sw);
                oT = __builtin_amdgcn_mfma_f32_16x16x32_bf16(sA, qB[kk], oT, 0, 0, 0);
                aT = __builtin_amdgcn_mfma_f32_16x16x32_bf16(kA[kk], qB[kk], aT, 0, 0, 0);
                asm volatile("" : "+v"(oT), "+v"(aT) : "v"(sA), "v"(qB[kk]), "v"(kA[kk]));
            }
            SETTLE();
#pragma unroll
            for (int i = 0; i < 4; ++i) if (4 * g + i > r16) aT[i] = 0.f;
            u32x2 aw; aw.x = pk2(aT[0], aT[1]); aw.y = pk2(aT[2], aT[3]);
#if MK_SUB != 1
            { const s16x4 aB = __builtin_bit_cast(s16x4, aw);
              oT = __builtin_amdgcn_mfma_f32_16x16x16bf16_1k(vA, aB, oT, 0, 0, 0);
              asm volatile("" : "+v"(oT) : "v"(vA), "v"(aB)); }
#else
            if (aw.x == 0x12345678u && aw.y == 0x9abcdef1u) oT[0] += 1.f;
#endif
            SETTLE();
            *(f32x4*)(Os + (sb * 16 + r16) * 132 + 16 * wave + 4 * g) = oT;
#if MK_VAR == 4
            { u32x2 w; w.x = pk2(oT[0], oT[1]); w.y = pk2(oT[2], oT[3]);
              *(u32x2*)(WS_PTR(bf16_t, WS_MRG) + (size_t)(t0 + sb * 16 + r16) * 2048 + 1024 + h * 128 + 16 * wave + 4 * g) = w; }
#endif
        }
#pragma unroll
        for (int kt = 0; kt < 8; ++kt) {
            const f32x4 d4 = *(const f32x4*)(Ds + sb * 128 + 16 * kt + 4 * g);
            const s16x4 khA = *(const s16x4*)(KHt + (sb * 128 + 16 * kt + r16) * 16 + 4 * g);
            S[kt] = __builtin_amdgcn_mfma_f32_16x16x16bf16_1k(khA, vA, S[kt] * d4, 0, 0, 0);
            asm volatile("" : "+v"(S[kt]) : "v"(khA), "v"(vA));
        }
        SETTLE();
    }
    if (!OUT) {
        if (tid < 128) dtot *= Ds[tid] * Ds[128 + tid] * Ds[256 + tid] * Ds[384 + tid];
    } else {
        __syncthreads();
        const int t = tid >> 3, j = tid & 7;
        const float* orow = Os + t * 132 + 16 * j;
        f32x4 ov[4]; float ss = 0.f;
#pragma unroll
        for (int q = 0; q < 4; ++q) { ov[q] = ((const f32x4*)orow)[q]; ss += ov[q][0] * ov[q][0] + ov[q][1] * ov[q][1] + ov[q][2] * ov[q][2] + ov[q][3] * ov[q][3]; }
        ss += __shfl_xor(ss, 1); ss += __shfl_xor(ss, 2); ss += __shfl_xor(ss, 4);
        const float rstd = rsqrtf(ss * (1.f / 128.f) + EPS_);
        unsigned ow[8];
#pragma unroll
        for (int q = 0; q < 4; ++q) {
            const float a0 = ov[q][0] * rstd * gg[4 * q], a1 = ov[q][1] * rstd * gg[4 * q + 1];
            const float a2 = ov[q][2] * rstd * gg[4 * q + 2], a3 = ov[q][3] * rstd * gg[4 * q + 3];
            ow[2 * q] = pk2(a0, a1); ow[2 * q + 1] = pk2(a2, a3); }
        u32x4* mp = (u32x4*)(WS_PTR(bf16_t, WS_MRG) + (size_t)(t0 + t) * 2048 + 1024 + h * 128 + 16 * j);
#if MK_VAR != 4
        mp[0] = (u32x4){ow[0], ow[1], ow[2], ow[3]}; mp[1] = (u32x4){ow[4], ow[5], ow[6], ow[7]};
#else
        if (ow[0] == 0x12345678u && ow[7] == 0x9abcdef0u) mp[0] = (u32x4){ow[0], ow[1], ow[2], ow[3]};
#endif
    }
    __syncthreads();
    }
#undef HG_LOADS
    if (!OUT) {
#pragma unroll
        for (int kt = 0; kt < 8; ++kt)
#pragma unroll
            for (int i = 0; i < 4; ++i) Ub[(size_t)(16 * kt + 4 * g + i) * 128] = S[kt][i];
        if (tid < 128) WS_PTR(float, WS_DD)[(size_t)(c * 8 + h) * 128 + tid] = dtot;
    }
}

__device__ __forceinline__ void gemm_stagger(int ticks) {
#if MK_STAG
    if ((xb_xcc_id() & 1u) && ticks > 0) { const unsigned long long t0 = __builtin_amdgcn_s_memrealtime(); while ((long long)(__builtin_amdgcn_s_memrealtime() - t0) < ticks) __builtin_amdgcn_s_sleep(8); }
#endif
}
__device__ __forceinline__ void phase_run(const Params& P, int ph, unsigned char* lds) {
    const int tid = threadIdx.x, wave = __builtin_amdgcn_readfirstlane(tid >> 6), lane = tid & 63;
    const int gw = blockIdx.x * 8 + wave, NGW = gridDim.x * 8;
    float* lf = (float*)lds;
    pg8::StaticOrder SO;
#ifdef ONLY_PH
    if (ph != ONLY_PH) return; ph = ONLY_PH;
#endif
    switch (ph) {
    case 0: {
        float* scr = (float*)(lds + wave * 8448);
        constexpr int I_IN = 32 * 224, I_OUT = 32 * 64, I_G = 32 * 176, I_D = 88 * 64;
        for (int it = gw; it < I_IN + I_OUT + 2 * I_G + I_D; it += NGW) {
            int r = it;
            if (r < I_IN) { transpose_item(P.w_in, 2048, NIN, WS_PTR(bf16_t, WS_WIN), 1 << 20, 0, 0, scr, r, lane); continue; } r -= I_IN;
            if (r < I_OUT) { transpose_item(P.w_out, 2048, 2048, WS_PTR(bf16_t, WS_WOUT), 1 << 20, 0, 0, scr, r, lane); continue; } r -= I_OUT;
            if (r < I_G) { transpose_item(P.w_gate, 2048, DFF, WS_PTR(bf16_t, WS_WGU), 128, 256, 0, scr, r, lane); continue; } r -= I_G;
            if (r < I_G) { transpose_item(P.w_up, 2048, DFF, WS_PTR(bf16_t, WS_WGU), 128, 256, 128, scr, r, lane); continue; } r -= I_G;
            transpose_item(P.w_down, DFF, 2048, WS_PTR(bf16_t, WS_WD), 1 << 20, 0, 0, scr, r, lane);
        }
        { int row = gw;
          for (; row + NGW < T_; row += 2 * NGW) rms_row2_bf16(P.x_prompt + (size_t)row * 2048, P.n_pre_mix, WS_PTR(bf16_t, WS_H) + (size_t)row * 2048, (size_t)NGW * 2048, lane);
          for (; row < T_ + NBS; row += NGW) {
            if (row < T_) rms_row_bf16(P.x_prompt + (size_t)row * 2048, P.n_pre_mix, WS_PTR(bf16_t, WS_H) + (size_t)row * 2048, lane);
            else rms_row_bf16(P.x_sample + (size_t)(row - T_) * 2048, P.n_pre_mix, WS_PTR(bf16_t, WS_HS) + (size_t)(row - T_) * 2048, lane);
          } }
    } break;
    case 1: {
        float* projs = WS_PTR(float, WS_PROJS);
        { int i0 = -1, istep = 0;
          if (gridDim.x == 256) { const int x = blockIdx.x & 7, j = blockIdx.x >> 3;
              if (x < 6) { i0 = j * 6 + x; istep = 192; if (i0 + 192 >= 384) {} } else { i0 = 384 + j * 2 + (x - 6); istep = 1 << 20; } }
          if (gridDim.x == 256 && (blockIdx.x & 7) < 6) {
              skinny_gemm(WS_PTR(const bf16_t, WS_HS), WS_PTR(const bf16_t, WS_WIN), 2048, 384 * 16, lf, [=](int row, int col, float v) { projs[(size_t)row * NIN + col] = v; }, i0, istep);
          } else
              skinny_gemm(WS_PTR(const bf16_t, WS_HS), WS_PTR(const bf16_t, WS_WIN), 2048, NIN, lf, [=](int row, int col, float v) { projs[(size_t)row * NIN + col] = v; }, i0, istep); }
        pg8::Gemm gm{WS_PTR(const bf16_t, WS_H), WS_PTR(const bf16_t, WS_WIN), T_, NIN, 2048};
        SO.init(T_, NIN, (int)gridDim.x, (int)blockIdx.x);
        EpiIn E{WS_PTR(bf16_t, WS_QC), WS_PTR(bf16_t, WS_KC), WS_PTR(bf16_t, WS_VT), WS_PTR(bf16_t, WS_HG), P.out + O_WKP, P.out + O_WVP, 0.08838834764831845f * 1.4426950408889634f};
        gemm_stagger(800);
        RotOrder RO; RO.init(T_, NIN, (int)gridDim.x, (int)blockIdx.x);
        pg8::gemm_phase<EpiIn, RotOrder, false>((PG8_LAS unsigned char*)lds, gm, RO, E, nullptr);
    } break;
    case 2: {
        if ((gridDim.x & 7) == 0) {
            const int hh = blockIdx.x & 7, lw = (blockIdx.x >> 3) * 8 + wave, nlw = gridDim.x;
            for (int j = lw; j < 1024; j += nlw) attn_item(P, hh * 1024 + j, lane);
        } else {
            for (int it = gw; it < 8192; it += NGW) attn_item(P, it, lane);
        }
        __syncthreads();
        for (int it = blockIdx.x; it < 256; it += gridDim.x) { sattn_item(P, it, lf); shgrn_item(P, it, lf); }
        for (int it = blockIdx.x; it < 8 * NCH; it += gridDim.x) hgrn_item<false>(P, it, lds);
    } break;
    case 3: {
        float* U = WS_PTR(float, WS_U); const float* DD = WS_PTR(const float, WS_DD);
        for (int e = blockIdx.x * 512 + tid; e < 8 * 128 * 128; e += gridDim.x * 512) {
            const int hk = e >> 7; float S = 0.f;
#pragma unroll 32
            for (int c = 0; c < NCH; ++c) { const float u = U[(size_t)c * 131072 + e]; const float d = DD[c * 1024 + hk]; U[(size_t)c * 131072 + e] = S; S = d * S + u; }
            P.out[O_STP + e] = S;
        }
        if (gw < NBS) {
            const float* oa = WS_PTR(const float, WS_OATTS) + gw * 1024; const float* oh = WS_PTR(const float, WS_OHGS) + gw * 1024; bf16_t* mr = WS_PTR(bf16_t, WS_MRGS) + gw * 2048;
            f32x4 v[4]; float ss = 0.f;
#pragma unroll
            for (int j = 0; j < 4; ++j) { v[j] = ((const f32x4*)oa)[lane + 64 * j]; ss += v[j][0] * v[j][0] + v[j][1] * v[j][1] + v[j][2] * v[j][2] + v[j][3] * v[j][3]; }
            const float r = rsqrtf(wave_sum(ss) * (1.f / 1024.f) + EPS_);
#pragma unroll
            for (int j = 0; j < 4; ++j) { const f32x4 gv = ((const f32x4*)P.attn_gain)[lane + 64 * j]; const f32x4 hv = ((const f32x4*)oh)[lane + 64 * j];
                u32x2 w; w.x = pk2(v[j][0] * r * gv[0], v[j][1] * r * gv[1]); w.y = pk2(v[j][2] * r * gv[2], v[j][3] * r * gv[3]); ((u32x2*)mr)[lane + 64 * j] = w;
                u32x2 w2; w2.x = pk2(hv[0], hv[1]); w2.y = pk2(hv[2], hv[3]); ((u32x2*)(mr + 1024))[lane + 64 * j] = w2; }
        }
    } break;
    case 4: {
        float* mixs = WS_PTR(float, WS_MIXS);
        skinny_gemm(WS_PTR(const bf16_t, WS_MRGS), WS_PTR(const bf16_t, WS_WOUT), 2048, 2048, lf, [=](int row, int col, float v) { mixs[(size_t)row * 2048 + col] = v; });
        for (int it = blockIdx.x; it < 8 * NCH; it += gridDim.x) hgrn_item<true>(P, it, lds);
        for (int row0 = gw; row0 < T_; row0 += 4 * NGW) {
            u32x4 w[4][2]; float ss[4];
#pragma unroll
            for (int q4 = 0; q4 < 4; ++q4) { const int row = row0 + q4 * NGW; const int rr = row < T_ ? row : row0;
                const u32x4* ip = (const u32x4*)(WS_PTR(const bf16_t, WS_OATT) + (size_t)rr * 1024) + lane * 2; w[q4][0] = ip[0]; w[q4][1] = ip[1]; }
#pragma unroll
            for (int q4 = 0; q4 < 4; ++q4) { float a = 0.f;
#pragma unroll
                for (int q = 0; q < 2; ++q) { const u32x4 v = w[q4][q];
                    a += bflo(v.x) * bflo(v.x) + bfhi(v.x) * bfhi(v.x) + bflo(v.y) * bflo(v.y) + bfhi(v.y) * bfhi(v.y) + bflo(v.z) * bflo(v.z) + bfhi(v.z) * bfhi(v.z) + bflo(v.w) * bflo(v.w) + bfhi(v.w) * bfhi(v.w); }
                ss[q4] = a; }
#pragma unroll
            for (int q4 = 0; q4 < 4; ++q4) ss[q4] = rsqrtf(wave_sum(ss[q4]) * (1.f / 1024.f) + EPS_);
#pragma unroll
            for (int q4 = 0; q4 < 4; ++q4) { const int row = row0 + q4 * NGW; if (row >= T_) break; const float r = ss[q4];
                u32x4* op = (u32x4*)(WS_PTR(bf16_t, WS_MRG) + (size_t)row * 2048) + lane * 2;
#pragma unroll
                for (int q = 0; q < 2; ++q) { const u32x4 v = w[q4][q]; const f32x4 g0 = ((const f32x4*)P.attn_gain)[lane * 4 + q * 2], g1 = ((const f32x4*)P.attn_gain)[lane * 4 + q * 2 + 1];
                    u32x4 o; o.x = pk2(bflo(v.x) * r * g0[0], bfhi(v.x) * r * g0[1]); o.y = pk2(bflo(v.y) * r * g0[2], bfhi(v.y) * r * g0[3]);
                    o.z = pk2(bflo(v.z) * r * g1[0], bfhi(v.z) * r * g1[1]); o.w = pk2(bflo(v.w) * r * g1[2], bfhi(v.w) * r * g1[3]); op[q] = o; } }
        }
    } break;
    case 5: {
        if (gw < NBS) post_mix_row(P.x_sample + (size_t)gw * 2048, WS_PTR(const float, WS_MIXS) + (size_t)gw * 2048, P.n_post_mix, P.n_pre_ffn, P.out + O_YS + (size_t)gw * 2048, WS_PTR(bf16_t, WS_H2S) + (size_t)gw * 2048, lane);
        pg8::Gemm gm{WS_PTR(const bf16_t, WS_MRG), WS_PTR(const bf16_t, WS_WOUT), T_, 2048, 2048};
        SO.init(T_, 2048, (int)gridDim.x, (int)blockIdx.x);
        EpiBf16P E{WS_PTR(bf16_t, WS_MIX), 2048};
        gemm_stagger(800);
        pg8::gemm_phase<EpiBf16P, pg8::StaticOrder, false>((PG8_LAS unsigned char*)lds, gm, SO, E, nullptr);
    } break;
    case 6: {
        skinny_gu(WS_PTR(const bf16_t, WS_H2S), WS_PTR(const bf16_t, WS_WGU), WS_PTR(bf16_t, WS_FFS), lf);
#if MK_DBG == 1
        for (int row = gw; row < T_; row += NGW) for (int c = lane; c < 2048; c += 64) P.out[O_YP + (size_t)row * 2048 + c] = bf2f(WS_PTR(const bf16_t, WS_MRG)[(size_t)row * 2048 + c]);
#elif MK_DBG == 4
        for (int row = gw; row < T_; row += NGW) for (int c = lane; c < 2048; c += 64) P.out[O_YP + (size_t)row * 2048 + c] = bf2f(WS_PTR(const bf16_t, WS_HG)[(size_t)row * 4096 + c]);
#elif MK_DBG == 5
        for (int row = gw; row < T_; row += NGW) for (int c = lane; c < 2048; c += 64) P.out[O_YP + (size_t)row * 2048 + c] = (c >= 1024) ? 0.f : bf2f(WS_PTR(const bf16_t, WS_OATT)[(size_t)row * 1024 + c]);
#elif MK_DBG == 6
        for (size_t i = (size_t)blockIdx.x * 512 + tid; i < (size_t)T_ * 2048; i += (size_t)gridDim.x * 512) P.out[O_YP + i] = WS_PTR(const float, WS_U)[i];
#elif MK_DBG == 7
        for (int row = gw; row < T_; row += NGW) for (int c = lane; c < 2048; c += 64) P.out[O_YP + (size_t)row * 2048 + c] = bf2f(WS_PTR(const bf16_t, WS_HG)[(size_t)row * 4096 + 2048 + c]);
#elif MK_DBG == 2
        for (int row = gw; row < T_; row += NGW) for (int c = lane; c < 2048; c += 64) P.out[O_YP + (size_t)row * 2048 + c] = (c < 1024) ? 0.f : bf2f(WS_PTR(const bf16_t, WS_MRG)[(size_t)row * 2048 + c]);
#else
        { int row = gw;
          for (; row + NGW < T_; row += 2 * NGW)
            post_mix_row2(P.x_prompt + (size_t)row * 2048, WS_PTR(const bf16_t, WS_MIX) + (size_t)row * 2048, P.n_post_mix, P.n_pre_ffn, WS_PTR(bf16_t, WS_MRG) + (size_t)row * 2048, WS_PTR(bf16_t, WS_H) + (size_t)row * 2048, (size_t)NGW * 2048, lane);
          for (; row < T_; row += NGW)
            post_mix_row(P.x_prompt + (size_t)row * 2048, WS_PTR(const bf16_t, WS_MIX) + (size_t)row * 2048, P.n_post_mix, P.n_pre_ffn, WS_PTR(bf16_t, WS_MRG) + (size_t)row * 2048, WS_PTR(bf16_t, WS_H) + (size_t)row * 2048, lane); }
#endif
    } break;
    case 7: {
        float* ffos = WS_PTR(float, WS_FFOS);
        { int i0 = -1, istep = 0;
          if (gridDim.x == 256) { const int x = blockIdx.x & 7, j = blockIdx.x >> 3; i0 = (x < 4) ? (j * 4 + x) : (1 << 20); istep = 1 << 20; }
          skinny_gemm(WS_PTR(const bf16_t, WS_FFS), WS_PTR(const bf16_t, WS_WD), DFF, 2048, lf, [=](int row, int col, float v) { ffos[(size_t)row * 2048 + col] = v; }, i0, istep); }
        pg8::Gemm gm{WS_PTR(const bf16_t, WS_H), WS_PTR(const bf16_t, WS_WGU), T_, 2 * DFF, 2048};
        SO.init(T_, 2 * DFF, (int)gridDim.x, (int)blockIdx.x);
        EpiSwiGLU E{WS_PTR(bf16_t, WS_FF)};
        gemm_stagger(500);
        pg8::gemm_phase<EpiSwiGLU, pg8::StaticOrder, false>((PG8_LAS unsigned char*)lds, gm, SO, E, nullptr);
    } break;
    case 8: {
        if (gw < NBS) final_row(P.out + O_YS + (size_t)gw * 2048, WS_PTR(const float, WS_FFOS) + (size_t)gw * 2048, P.n_post_ffn, P.out + O_YS + (size_t)gw * 2048, lane);
        pg8::Gemm gm{WS_PTR(const bf16_t, WS_FF), WS_PTR(const bf16_t, WS_WD), T_, 2048, DFF};
        SO.init(T_, 2048, (int)gridDim.x, (int)blockIdx.x);
        EpiBf16P E{WS_PTR(bf16_t, WS_MIX), 2048};
        gemm_stagger(800);
        pg8::gemm_phase<EpiBf16P, pg8::StaticOrder, false>((PG8_LAS unsigned char*)lds, gm, SO, E, nullptr);
    } break;
    case 9: {
        { int row = gw;
          for (; row + NGW < T_; row += 2 * NGW)
            final_row2(WS_PTR(const bf16_t, WS_MRG) + (size_t)row * 2048, WS_PTR(const bf16_t, WS_MIX) + (size_t)row * 2048, P.n_post_ffn, P.out + O_YP + (size_t)row * 2048, (size_t)NGW * 2048, lane);
          for (; row < T_; row += NGW)
            final_row(WS_PTR(const bf16_t, WS_MRG) + (size_t)row * 2048, WS_PTR(const bf16_t, WS_MIX) + (size_t)row * 2048, P.n_post_ffn, P.out + O_YP + (size_t)row * 2048, lane); }
    } break;
    default: break;
    }
}

__global__ __launch_bounds__(512, 2) void hymba_fwd(Params P) {
    extern __shared__ __attribute__((aligned(16))) unsigned char shm[];
    cg::grid_group grid = cg::this_grid();
#ifdef TEST_NOLOOP
    phase_run(P, ONLY_PH, shm);
#else
    volatile LAS unsigned* xst = (volatile LAS unsigned*)(shm + 131072);
    if (threadIdx.x < 4) xst[threadIdx.x] = 0u;
    __syncthreads();
    XcdBarrier xb = xcd_barrier_post((unsigned*)(P.ws + WS_BAR), xst);
#if MK_TIMER
    unsigned long long tsv[11]; tsv[0] = __builtin_amdgcn_s_memrealtime();
#define RUN_PH(n) if (P.ph_lo <= n && n < P.ph_hi) { phase_run(P, n, shm); grid.sync(); tsv[n + 1] = __builtin_amdgcn_s_memrealtime(); }
#else
#define RUN_PH(n) if (P.ph_lo <= n && n < P.ph_hi) { phase_run(P, n, shm); if (n + 1 < P.ph_hi) { if (n == MK_CGSEAM) grid.sync(); else xcd_barrier(xb); } }
#endif
    RUN_PH(0) RUN_PH(1) RUN_PH(2) RUN_PH(3) RUN_PH(4) RUN_PH(5) RUN_PH(6) RUN_PH(7) RUN_PH(8) RUN_PH(9)
#if MK_XSYNC
    for (int i = 0; i < MK_XSYNC; ++i) grid.sync();
#endif
    if (P.ph_hi > 1000) grid.sync();
#if MK_TIMER
    if (blockIdx.x == 0) {
        float d[10];
#pragma unroll
        for (int i = 0; i < 10; ++i) d[i] = (float)(tsv[i + 1] - tsv[i]) * 0.01f;
        const float* tw = WS_PTR(const float, WS_SSQ); (void)tw;
        const float T1 = MK_T1, T2 = MK_T2;
        if (threadIdx.x == 0) P.out[O_YS] += T1 * 0.01f;
        for (int i = threadIdx.x; i < 32768; i += 512) P.out[O_WKS + i] += T2 * 0.001f;
    }
#endif
#endif
}

extern "C" void kernel_launch(void* const* d_in, const int* in_sizes, int n_in, void* d_out, int out_size, void* d_ws, size_t ws_size, hipStream_t stream) {
    static int grid = 0;
    if (grid == 0) {
        if (ws_size < WS_END) { fprintf(stderr, "kernel_launch: workspace too small (%zu < %zu)\n", ws_size, (size_t)WS_END); grid = -1; return; }
        int dev = 0, cus = 0, per_cu = 0;
        hipGetDevice(&dev);
        hipDeviceGetAttribute(&cus, hipDeviceAttributeMultiprocessorCount, dev);
        if (hipFuncSetAttribute((const void*)hymba_fwd, hipFuncAttributeMaxDynamicSharedMemorySize, LDS_BYTES) != hipSuccess) { fprintf(stderr, "kernel_launch: hipFuncSetAttribute failed\n"); grid = -1; return; }
        if (hipOccupancyMaxActiveBlocksPerMultiprocessor(&per_cu, (const void*)hymba_fwd, 512, LDS_BYTES) != hipSuccess || per_cu < 1) { fprintf(stderr, "kernel_launch: occupancy query says %d\n", per_cu); per_cu = 1; }
        (void)hipGetLastError();
        grid = cus;
    }
    if (grid < 0) return;
    Params p{};
    p.x_prompt = (const float*)d_in[0]; p.x_sample = (const float*)d_in[1]; p.cache_k = (const float*)d_in[2]; p.cache_v = (const float*)d_in[3]; p.state_in = (const float*)d_in[4];
    p.n_pre_mix = (const float*)d_in[5]; p.w_in = (const float*)d_in[6]; p.lb_logits = (const float*)d_in[7]; p.attn_gain = (const float*)d_in[8]; p.hg_gain = (const float*)d_in[9];
    p.w_out = (const float*)d_in[10]; p.n_post_mix = (const float*)d_in[11]; p.n_pre_ffn = (const float*)d_in[12]; p.w_gate = (const float*)d_in[13]; p.w_up = (const float*)d_in[14];
    p.w_down = (const float*)d_in[15]; p.n_post_ffn = (const float*)d_in[16];
    p.out = (float*)d_out; p.ws = (unsigned char*)d_ws;
    if (hipMemsetAsync((char*)d_ws + WS_BAR, 0, 3456 * 4, stream) != hipSuccess) { fprintf(stderr, "kernel_launch: barrier memset failed\n"); return; }
#if MK_FUSED
    p.ph_lo = 0; p.ph_hi = 10;
    { void* args[] = {&p}; hipError_t e = hipLaunchCooperativeKernel((const void*)hymba_fwd, dim3(grid), dim3(512), args, LDS_BYTES, stream);
      if (e != hipSuccess) fprintf(stderr, "cooperative launch failed: %s (grid %d)\n", hipGetErrorString(e), grid); }
#else
    for (int ph = 0; ph < MK_NPH; ++ph) { p.ph_lo = ph; p.ph_hi = ph + 1; void* args[] = {&p};
      hipError_t e = hipLaunchCooperativeKernel((const void*)hymba_fwd, dim3(grid), dim3(512), args, LDS_BYTES, stream);
      if (e != hipSuccess) fprintf(stderr, "launch %d failed: %s (grid %d)\n", ph, hipGetErrorString(e), grid); }
#endif
}
```

```cpp
#include <hip/hip_runtime.h>
#include <hip/hip_cooperative_groups.h>
#include <cstdio>
namespace cg = cooperative_groups;

#ifndef MK_SETTLE
#define MK_SETTLE 0
#endif
#ifndef MK_VAR
#define MK_VAR 0
#endif
#ifndef MK_SUB
#define MK_SUB 0
#endif
#ifndef MK_TIMER
#define MK_TIMER 0
#define MK_T1 (d[0])
#define MK_T2 (d[3])
#endif
#ifndef MK_ATTPROBE
#define MK_ATTPROBE 0
#endif
#ifndef MK_XSYNC
#define MK_XSYNC 0
#endif
#ifndef MK_CGSEAM
#define MK_CGSEAM (-1)
#endif
#ifndef MK_STAG
#define MK_STAG 0
#endif
#ifndef MK_DBG
#define MK_DBG 0
#endif
#ifndef MK_NPH
#define MK_NPH 10
#endif
#ifndef MK_FUSED
#define MK_FUSED 1
#endif

typedef unsigned short bf16_t;
typedef short s16x8 __attribute__((ext_vector_type(8)));
typedef short s16x4 __attribute__((ext_vector_type(4)));
typedef float f32x4 __attribute__((ext_vector_type(4)));
typedef unsigned u32x4 __attribute__((ext_vector_type(4)));
typedef unsigned u32x2 __attribute__((ext_vector_type(2)));

constexpr int T_ = 16384, D_ = 2048, NIN = 7168, DFF = 5632, NBS = 32, PAST = 2048;
constexpr int NCH = 64;
constexpr float EPS_ = 1e-6f;
constexpr int LDS_BYTES = 131072 + 256;

constexpr size_t WS_WIN = 0;
constexpr size_t WS_WOUT = WS_WIN + (size_t)NIN * D_ * 2;
constexpr size_t WS_WGU = WS_WOUT + (size_t)D_ * D_ * 2;
constexpr size_t WS_WD = WS_WGU + (size_t)2 * DFF * D_ * 2;
constexpr size_t WS_H = WS_WD + (size_t)D_ * DFF * 2;
constexpr size_t WS_QC = WS_H + (size_t)T_ * D_ * 2;
constexpr size_t WS_KC = WS_QC + (size_t)T_ * 1024 * 2;
constexpr size_t WS_VT = WS_KC + (size_t)T_ * 1024 * 2;
constexpr size_t WS_HG = WS_VT + (size_t)T_ * 1024 * 2;
constexpr size_t WS_FF = WS_QC;
constexpr size_t WS_OATT = WS_HG + (size_t)T_ * 4096 * 2;
constexpr size_t WS_U = WS_OATT + (size_t)T_ * 1024 * 2;
constexpr size_t WS_DD = WS_U + (size_t)NCH * 8 * 128 * 128 * 4;
constexpr size_t WS_MRG = WS_DD + (size_t)NCH * 1024 * 4;
constexpr size_t WS_MIX = WS_MRG + (size_t)T_ * D_ * 2;
constexpr size_t WS_SSQ = WS_MIX + (size_t)T_ * D_ * 4;
constexpr size_t WS_S0 = WS_SSQ + (size_t)T_ * 4;
constexpr size_t WS_HS = WS_S0;
constexpr size_t WS_PROJS = WS_HS + 32 * 2048 * 2;
constexpr size_t WS_OATTS = WS_PROJS + 32 * 7168 * 4;
constexpr size_t WS_OHGS = WS_OATTS + 32 * 1024 * 4;
constexpr size_t WS_MRGS = WS_OHGS + 32 * 1024 * 4;
constexpr size_t WS_MIXS = WS_MRGS + 32 * 2048 * 2;
constexpr size_t WS_H2S = WS_MIXS + 32 * 2048 * 4;
constexpr size_t WS_FFS = WS_H2S + 32 * 2048 * 2;
constexpr size_t WS_FFOS = WS_FFS + 32 * 5632 * 2;
constexpr size_t WS_BAR = WS_FFOS + 32 * 2048 * 4;
constexpr size_t WS_END = WS_BAR + 3456 * 4 + 256;

constexpr size_t O_YP = 0;
constexpr size_t O_YS = O_YP + (size_t)T_ * D_;
constexpr size_t O_WKP = O_YS + 32 * 2048;
constexpr size_t O_WVP = O_WKP + (size_t)2048 * 1024;
constexpr size_t O_STP = O_WVP + (size_t)2048 * 1024;
constexpr size_t O_WKS = O_STP + 8 * 128 * 128;
constexpr size_t O_WVS = O_WKS + 32 * 1024;
constexpr size_t O_STS = O_WVS + 32 * 1024;

struct Params {
    const float* x_prompt; const float* x_sample; const float* cache_k; const float* cache_v; const float* state_in;
    const float* n_pre_mix; const float* w_in; const float* lb_logits; const float* attn_gain; const float* hg_gain;
    const float* w_out; const float* n_post_mix; const float* n_pre_ffn; const float* w_gate; const float* w_up;
    const float* w_down; const float* n_post_ffn;
    float* out; unsigned char* ws;
    int ph_lo, ph_hi;
};

typedef __bf16 bf16x2v_ __attribute__((ext_vector_type(2)));
typedef float f32x2v_ __attribute__((ext_vector_type(2)));
__device__ __forceinline__ unsigned pk2(float lo, float hi) { const f32x2v_ f = {lo, hi}; const bf16x2v_ b = __builtin_convertvector(f, bf16x2v_); return __builtin_bit_cast(unsigned, b); }
__device__ __forceinline__ bf16_t f2bf(float f) { unsigned u = __float_as_uint(f); u += 0x7FFFu + ((u >> 16) & 1u); return (bf16_t)(u >> 16); }
__device__ __forceinline__ float bf2f(bf16_t b) { return __uint_as_float(((unsigned)b) << 16); }
__device__ __forceinline__ float bflo(unsigned w) { return __uint_as_float(w << 16); }
__device__ __forceinline__ float bfhi(unsigned w) { return __uint_as_float(w & 0xffff0000u); }
__device__ __forceinline__ float wave_sum(float v) {
#pragma unroll
    for (int o = 1; o < 64; o <<= 1) v += __shfl_xor(v, o);
    return v;
}
__device__ __forceinline__ float sigmoidf_(float x) { return __builtin_amdgcn_rcpf(1.f + __expf(-x)); }
__device__ __forceinline__ float siluf_(float x) { return x * __builtin_amdgcn_rcpf(1.f + __expf(-x)); }

#define XB_TMO      128
#define XB_XCNT(j)  (256  + 64 * (j))
#define XB_XSUB(j)  (1280 + 64 * (j))
#define XB_XGEN(j)  (2304 + 64 * (j))
#define XB_TOP      3328
#define XB_TOPGEN   3392
#define XCD_BAR_WORDS 3456
#define XB_SPIN_CAP (1u << 18)
#define LAS __attribute__((address_space(3)))

__device__ __forceinline__ unsigned xb_ld(unsigned* p)              { return __hip_atomic_load(p, __ATOMIC_RELAXED, __HIP_MEMORY_SCOPE_AGENT); }
__device__ __forceinline__ unsigned xb_add(unsigned* p, unsigned v) { return __hip_atomic_fetch_add(p, v, __ATOMIC_RELAXED, __HIP_MEMORY_SCOPE_AGENT); }
__device__ __forceinline__ unsigned xb_xcc_id() { return (unsigned)__builtin_amdgcn_s_getreg((3 << 11) | 20) & 0xFu; }
#define XB_SPIN(cond, bar) do { unsigned _sp = 0; while (cond) { __builtin_amdgcn_s_sleep(1); \
    if ((++_sp & 255u) == 0u) { if (xb_ld(&(bar)[XB_TMO])) break; if (_sp > XB_SPIN_CAP) { atomicAdd(&(bar)[XB_TMO], 1u); break; } } } } while (0)

struct XcdBarrier {
    unsigned* bar; unsigned x;
    volatile LAS unsigned* st;
};

__device__ __forceinline__ XcdBarrier xcd_barrier_post(unsigned* bar, volatile LAS unsigned* st) {
    XcdBarrier b; b.bar = bar; b.x = xb_xcc_id(); b.st = st;
    if (threadIdx.x == 0) (void)xb_add(&bar[XB_XCNT(b.x)], 1u);
    return b;
}
__device__ __forceinline__ void xcd_barrier_complete(unsigned* bar, unsigned x, unsigned& nloc, unsigned& nx) {
    const unsigned G = gridDim.x * gridDim.y * gridDim.z;
    unsigned sum, cnt, mine, sp = 0u;
    for (;;) {
        sum = 0u; cnt = 0u; mine = 0u;
#pragma unroll
        for (unsigned j = 0; j < 16; ++j) { const unsigned c = xb_ld(&bar[XB_XCNT(j)]); sum += c; cnt += (c > 0u) ? 1u : 0u; mine = (j == x) ? c : mine; }
        if (sum == G) break;
        __builtin_amdgcn_s_sleep(1);
        if ((++sp & 255u) == 0u) { if (xb_ld(&bar[XB_TMO])) break; if (sp > XB_SPIN_CAP) { atomicAdd(&bar[XB_TMO], 1u); break; } }
    }
    nloc = mine > 0u ? mine : 1u; nx = cnt > 0u ? cnt : 1u;
}

__device__ __forceinline__ void xcd_barrier(const XcdBarrier& b) {
    asm volatile("s_waitcnt vmcnt(0)" ::: "memory");
    __syncthreads();
    if (threadIdx.x == 0) {
        unsigned* bar = b.bar;
        __builtin_amdgcn_s_waitcnt(0);
        unsigned nloc = b.st[0], nx = b.st[1];
        if (nloc == 0u) { xcd_barrier_complete(bar, b.x, nloc, nx); b.st[0] = nloc; b.st[1] = nx; }
        const unsigned old = xb_add(&bar[XB_XSUB(b.x)], 1u);
        const unsigned gen = old / nloc;
        if (old + 1u == (gen + 1u) * nloc) {
            __builtin_amdgcn_fence(__ATOMIC_RELEASE, "agent");
            asm volatile("s_waitcnt vmcnt(0)" ::: "memory");
            const unsigned og = xb_add(&bar[XB_TOP], 1u);
            const unsigned tg = og / nx;
            if (og + 1u == (tg + 1u) * nx) xb_add(&bar[XB_TOPGEN], 1u);
            else XB_SPIN(xb_ld(&bar[XB_TOPGEN]) == tg, bar);
            __builtin_amdgcn_fence(__ATOMIC_ACQUIRE, "agent");
            xb_add(&bar[XB_XGEN(b.x)], 1u);
            asm volatile("s_waitcnt vmcnt(0)" ::: "memory");
        } else {
            XB_SPIN(xb_ld(&bar[XB_XGEN(b.x)]) == gen, bar);
            __builtin_amdgcn_fence(__ATOMIC_ACQUIRE, "agent");
            asm volatile("s_waitcnt vmcnt(0)" ::: "memory");
        }
    }
    __syncthreads();
}

namespace pg8 {
#define PG8_LAS __attribute__((address_space(3)))
typedef unsigned short bf16_t;
typedef short bf16x8 __attribute__((ext_vector_type(8)));
typedef float f32x4 __attribute__((ext_vector_type(4)));
typedef unsigned u32x4 __attribute__((ext_vector_type(4)));
constexpr int BM = 256, BK = 64, HALF = 128, HTB = HALF * BK * 2  , STAGE_BYTES = 8 * HTB, NXCD = 8, WGM = 8;

__host__ __device__ __forceinline__ int lds_byte(int r, int c) { const int st = (r >> 4) * 2 + (c >> 5), rr = r & 15, cc = c & 31, ob = rr * 64 + cc * 2; return st * 1024 + (ob ^ (((ob >> 9) & 1) << 5)); }
__host__ __device__ __forceinline__ void stage_rc(int b, int& R, int& C) { const int st = b / 1024, sb = b % 1024, swz = sb ^ (((sb >> 9) & 1) << 5); R = (st >> 1) * 16 + swz / 64; C = (st & 1) * 32 + (swz % 64) / 2; }
__host__ __device__ __forceinline__ int perm32(int rho) { const int n = rho >> 4, i = rho & 15; return 8 * (i >> 2) + 4 * n + (i & 3); }

struct Unit { int pm, pn; };
struct Gemm { const bf16_t* A; const bf16_t* Bt; int M, N, K; };

struct StaticOrder {
    int nM, nN, nwg, G, c;
    __host__ __device__ void init(int M, int N, int G_, int c_) { nM = M / BM; nN = N / BM; nwg = nM * nN; G = G_; c = c_; }
    __host__ __device__ bool next(int i, Unit& u) const {
        const long L = (long)i * G + c; if (L >= nwg) return false;
        int wgid = (int)L; { const int q = nwg / NXCD, r = nwg % NXCD, xcd = wgid % NXCD, off = wgid / NXCD; wgid = (xcd < r ? xcd * (q + 1) : r * (q + 1) + (xcd - r) * q) + off; }
        const int nig = WGM * nN, gid = wgid / nig, fm = gid * WGM, gsz = (nM - fm) < WGM ? (nM - fm) : WGM;
        u.pm = fm + ((wgid % nig) % gsz); u.pn = (wgid % nig) / gsz; return true;
    }
    __device__ __forceinline__ void a_ready(const Unit&) const {}
    __device__ __forceinline__ void done(const Unit&) const {}
};
__device__ __forceinline__ unsigned cvt_pk_bf16(float lo, float hi) { unsigned r; asm volatile("v_cvt_pk_bf16_f32 %0, %1, %2" : "=v"(r) : "v"(lo), "v"(hi)); return r; }
template <class Epi, class Sched, bool STAMP = false>
__device__ __forceinline__ void gemm_phase(PG8_LAS unsigned char* lds, const Gemm g, const Sched& S, const Epi& E, unsigned long long* stamps) {
    const int tid = threadIdx.x, wid = __builtin_amdgcn_readfirstlane(tid >> 6), lane = tid & 63, wr = wid >> 2, wc = wid & 3, fr = lane & 15, fq = lane >> 4;
    const int K = g.K, nt = K / BK;
    int ts_lo = 0, ts_hi = 0, nts = 0; const unsigned long long rt_entry = STAMP ? (unsigned long long)wall_clock64() : 0ull;
#define PG8_STAMP() do { if (STAMP && wid == 0 && nts < 64) { const unsigned long long _c = (unsigned long long)clock64(); \
        ts_lo = (lane == nts) ? (int)(unsigned)_c : ts_lo; ts_hi = (lane == nts) ? (int)(unsigned)(_c >> 32) : ts_hi; ++nts; } } while (0)
    PG8_STAMP();
    unsigned voffA[2], voffB[2];
#pragma unroll
    for (int i = 0; i < 2; ++i) { int R, C; stage_rc(tid * 16 + i * 8192, R, C); const int Rb = Epi::PERM ? ((R & ~31) + perm32(R & 31)) : R;
        voffA[i] = (unsigned)(R * K + C) * 2u; voffB[i] = (unsigned)(Rb * K + C) * 2u; }
    const size_t kstep = (size_t)(BK * 2);
    const size_t hstep = (size_t)HALF * K * 2;
    const size_t tstep = 2 * hstep;
    const unsigned ldsw = (unsigned)wid * 1024u;
    const int aoff = lds_byte(wr * 64 + fr, fq * 8), boff = lds_byte(wc * 32 + fr, fq * 8);
#define PG8_SA(b, h) (((b) * 2 + (h)) * HTB)
#define PG8_SB(b, h) ((4 + (b) * 2 + (h)) * HTB)
#define PG8_STAGE(bufoff, gbase, voff) do { _Pragma("unroll") for (int _i = 0; _i < 2; ++_i) \
        __builtin_amdgcn_global_load_lds((const unsigned*)((const char*)(gbase) + (voff)[_i]), (PG8_LAS unsigned*)(lds + (bufoff) + ldsw + _i * 8192), 16, 0, 0); } while (0)
#define PG8_LDA(dst, b, h) do { _Pragma("unroll") for (int m = 0; m < 4; ++m) _Pragma("unroll") for (int k = 0; k < 2; ++k) dst[m][k] = *(const PG8_LAS bf16x8*)(lds + PG8_SA(b, h) + aoff + m * 2048 + k * 1024); } while (0)
#define PG8_LDB(dst, b, h) do { _Pragma("unroll") for (int n = 0; n < 2; ++n) _Pragma("unroll") for (int k = 0; k < 2; ++k) dst[n][k] = *(const PG8_LAS bf16x8*)(lds + PG8_SB(b, h) + boff + n * 2048 + k * 1024); } while (0)
#define PG8_MMA(ai, bj, At, Bt) do { __builtin_amdgcn_s_setprio(1); _Pragma("unroll") for (int m = 0; m < 4; ++m) _Pragma("unroll") for (int n = 0; n < 2; ++n) _Pragma("unroll") for (int k = 0; k < 2; ++k) \
        acc[ai][bj][m][n] = __builtin_amdgcn_mfma_f32_16x16x32_bf16(Bt[n][k], At[m][k], acc[ai][bj][m][n], 0, 0, 0); __builtin_amdgcn_s_setprio(0); } while (0)
#define PG8_WAIT_V(n) asm volatile("s_waitcnt vmcnt(" #n ")" ::: "memory")
#define PG8_WAIT_L(n) asm volatile("s_waitcnt lgkmcnt(" #n ")" ::: "memory")
#define PG8_BAR __builtin_amdgcn_s_barrier()
#define PG8_SCHED __builtin_amdgcn_sched_barrier(0)
    Unit cur, nxt; int ui = 0;
    if (!S.next(0, cur)) return;
    f32x4 acc[2][2][4][2];
#pragma unroll
    for (int a = 0; a < 2; ++a)
#pragma unroll
        for (int b = 0; b < 2; ++b)
#pragma unroll
            for (int m = 0; m < 4; ++m)
#pragma unroll
                for (int n = 0; n < 2; ++n) acc[a][b][m][n] = (f32x4){0.f, 0.f, 0.f, 0.f};
    bf16x8 At[4][2], B0[2][2], B1[2][2];
    const char* cA = (const char*)g.A + (size_t)cur.pm * tstep; const char* cB = (const char*)g.Bt + (size_t)cur.pn * tstep;
    S.a_ready(cur);
    PG8_STAGE(PG8_SB(0, 0), cB, voffB); PG8_STAGE(PG8_SA(0, 0), cA, voffA); PG8_STAGE(PG8_SB(0, 1), cB + hstep, voffB); PG8_STAGE(PG8_SA(0, 1), cA + hstep, voffA);
    if (wr == 1) PG8_BAR;
    PG8_WAIT_V(4); PG8_BAR;
    PG8_STAGE(PG8_SB(1, 0), cB + kstep, voffB); PG8_STAGE(PG8_SA(1, 0), cA + kstep, voffA); PG8_STAGE(PG8_SB(1, 1), cB + hstep + kstep, voffB);
    PG8_WAIT_V(6); PG8_BAR;
    PG8_STAMP();
    for (;;) {
        const bool has_next = S.next(ui + 1, nxt);
        const char* nA = has_next ? (const char*)g.A + (size_t)nxt.pm * tstep : cA; const char* nB = has_next ? (const char*)g.Bt + (size_t)nxt.pn * tstep : cB;
        for (int t = 0; t < nt; t += 2) {
            const bool last = (t == nt - 2);
            const char* a1 = cA + (size_t)(t + 1) * kstep;
            const char* a2 = last ? nA : cA + (size_t)(t + 2) * kstep; const char* b2 = last ? nB : cB + (size_t)(t + 2) * kstep;
            const char* a3 = a2 + kstep; const char* b3 = b2 + kstep;
            if (last && has_next) S.a_ready(nxt);
            PG8_LDB(B0, 0, 0); PG8_SCHED; PG8_LDA(At, 0, 0); PG8_STAGE(PG8_SA(1, 1), a1 + hstep, voffA);
            PG8_WAIT_L(8); PG8_BAR; PG8_WAIT_L(0); PG8_MMA(0, 0, At, B0); PG8_BAR; PG8_SCHED;
            PG8_LDB(B1, 0, 1); PG8_STAGE(PG8_SB(0, 0), b2, voffB);
            PG8_BAR; PG8_WAIT_L(0); PG8_MMA(0, 1, At, B1); PG8_BAR;
            PG8_LDA(At, 0, 1); PG8_STAGE(PG8_SA(0, 0), a2, voffA);
            PG8_BAR; PG8_WAIT_L(0); PG8_MMA(1, 0, At, B0); PG8_BAR; PG8_SCHED;
            PG8_STAGE(PG8_SB(0, 1), b2 + hstep, voffB);
            PG8_WAIT_V(6); PG8_BAR; PG8_MMA(1, 1, At, B1); PG8_BAR;
            PG8_LDB(B0, 1, 0); PG8_SCHED; PG8_LDA(At, 1, 0); PG8_STAGE(PG8_SA(0, 1), a2 + hstep, voffA);
            PG8_WAIT_L(8); PG8_BAR; PG8_WAIT_L(0); PG8_MMA(0, 0, At, B0); PG8_BAR; PG8_SCHED;
            PG8_LDB(B1, 1, 1); PG8_STAGE(PG8_SB(1, 0), b3, voffB);
            PG8_BAR; PG8_WAIT_L(0); PG8_MMA(0, 1, At, B1); PG8_BAR;
            PG8_LDA(At, 1, 1); PG8_STAGE(PG8_SA(1, 0), a3, voffA);
            PG8_BAR; PG8_WAIT_L(0); PG8_MMA(1, 0, At, B0); PG8_BAR; PG8_SCHED;
            PG8_STAGE(PG8_SB(1, 1), b3 + hstep, voffB);
            PG8_WAIT_V(6); PG8_BAR; PG8_MMA(1, 1, At, B1); PG8_BAR;
        }
        PG8_STAMP();
        if constexpr (!Epi::AFTER_DRAIN) { E(acc, cur, wr, wc, fr, fq); S.done(cur); }
        PG8_STAMP();
        if (!has_next) break;
#pragma unroll
        for (int a = 0; a < 2; ++a)
#pragma unroll
            for (int b = 0; b < 2; ++b)
#pragma unroll
                for (int m = 0; m < 4; ++m)
#pragma unroll
                    for (int n = 0; n < 2; ++n) acc[a][b][m][n] = (f32x4){0.f, 0.f, 0.f, 0.f};
        cur = nxt; cA = nA; cB = nB; ++ui;
    }
    PG8_WAIT_V(0);
    if (wr == 0) PG8_BAR;
    PG8_BAR;
    if constexpr (Epi::AFTER_DRAIN) { E.fused(acc, cur, wr, wc, fr, fq, lds, wid, lane); S.done(cur); }
    PG8_STAMP();
    if (STAMP && wid == 0) { stamps[lane] = lane < nts ? (((unsigned long long)(unsigned)ts_hi << 32) | (unsigned)ts_lo) : 0ull;
        if (lane == 62) stamps[62] = rt_entry; if (lane == 63) stamps[63] = (unsigned long long)wall_clock64(); }
#undef PG8_STAMP
#undef PG8_SA
#undef PG8_SB
#undef PG8_STAGE
#undef PG8_LDA
#undef PG8_LDB
#undef PG8_MMA
#undef PG8_WAIT_V
#undef PG8_WAIT_L
#undef PG8_BAR
#undef PG8_SCHED
}
}

using pg8::Unit;
struct EpiF32 {
    static constexpr bool PERM = false, AFTER_DRAIN = false;
    float* C; int ldc;
    __device__ __forceinline__ void operator()(const f32x4 (&acc)[2][2][4][2], const Unit& u, int wr, int wc, int fr, int fq) const {
        const int row0 = u.pm * 256 + wr * 64 + fr, col0 = u.pn * 256 + wc * 32 + 4 * fq;
#pragma unroll
        for (int ai = 0; ai < 2; ++ai)
#pragma unroll
            for (int m = 0; m < 4; ++m) { float* rowp = C + (size_t)(row0 + ai * 128 + m * 16) * ldc + col0;
#pragma unroll
                for (int bj = 0; bj < 2; ++bj)
#pragma unroll
                    for (int n = 0; n < 2; ++n) *(f32x4*)(rowp + bj * 128 + n * 16) = acc[ai][bj][m][n]; }
    }
};
struct EpiBf16P {
    static constexpr bool PERM = true, AFTER_DRAIN = false;
    bf16_t* O; int ldc;
    __device__ __forceinline__ void operator()(const f32x4 (&acc)[2][2][4][2], const Unit& u, int wr, int wc, int fr, int fq) const {
        const int row0 = u.pm * 256 + wr * 64 + fr, col0 = u.pn * 256 + wc * 32 + 8 * fq;
#pragma unroll
        for (int ai = 0; ai < 2; ++ai)
#pragma unroll
            for (int m = 0; m < 4; ++m) { bf16_t* rowp = O + (size_t)(row0 + ai * 128 + m * 16) * ldc + col0;
#pragma unroll
                for (int bj = 0; bj < 2; ++bj) { const f32x4 v0 = acc[ai][bj][m][0], v1 = acc[ai][bj][m][1];
                    u32x4 w; w.x = pk2(v0[0], v0[1]); w.y = pk2(v0[2], v0[3]); w.z = pk2(v1[0], v1[1]); w.w = pk2(v1[2], v1[3]);
                    *(u32x4*)(rowp + bj * 128) = w; } }
    }
};
struct EpiSwiGLU {
    static constexpr bool PERM = true, AFTER_DRAIN = false;
    bf16_t* FF;
    __device__ __forceinline__ void operator()(const f32x4 (&acc)[2][2][4][2], const Unit& u, int wr, int wc, int fr, int fq) const {
        const int row0 = u.pm * 256 + wr * 64 + fr, col0 = u.pn * 128 + wc * 32 + 8 * fq;
#pragma unroll
        for (int ai = 0; ai < 2; ++ai)
#pragma unroll
            for (int m = 0; m < 4; ++m) {
                const f32x4 g0 = acc[ai][0][m][0], g1 = acc[ai][0][m][1], u0 = acc[ai][1][m][0], u1 = acc[ai][1][m][1];
                u32x4 w;
                w.x = pk2(siluf_(g0[0]) * u0[0], siluf_(g0[1]) * u0[1]); w.y = pk2(siluf_(g0[2]) * u0[2], siluf_(g0[3]) * u0[3]);
                w.z = pk2(siluf_(g1[0]) * u1[0], siluf_(g1[1]) * u1[1]); w.w = pk2(siluf_(g1[2]) * u1[2], siluf_(g1[3]) * u1[3]);
                *(u32x4*)(FF + (size_t)(row0 + ai * 128 + m * 16) * DFF + col0) = w; }
    }
};
struct RotOrder : pg8::StaticOrder {
    __device__ __forceinline__ bool next(int i, Unit& u) const { if (!pg8::StaticOrder::next(i, u)) return false; u.pn = u.pn + 12; if (u.pn >= 28) u.pn -= 28; return true; }
};
struct EpiIn {
    static constexpr bool PERM = true, AFTER_DRAIN = false;
    bf16_t* QC; bf16_t* KC; bf16_t* VT; bf16_t* HG; float* outk; float* outv; float qscale;
    __device__ __forceinline__ void operator()(const f32x4 (&acc)[2][2][4][2], const Unit& u, int wr, int wc, int fr, int fq) const {
        const int region = u.pn >> 2;
        if (region == 2) {
#pragma unroll
            for (int ai = 0; ai < 2; ++ai)
#pragma unroll
                for (int bj = 0; bj < 2; ++bj) {
                    const int h = (u.pn & 3) * 2 + bj, d = wc * 32 + 8 * fq;
                    bf16_t* vb = VT + (((size_t)(h * 16 + fr) * 64 + u.pm) * 128 + d) * 16 + ai * 8 + wr * 4;
#pragma unroll
                    for (int n = 0; n < 2; ++n)
#pragma unroll
                        for (int j = 0; j < 4; ++j) { u32x2 w; w.x = pk2(acc[ai][bj][0][n][j], acc[ai][bj][1][n][j]); w.y = pk2(acc[ai][bj][2][n][j], acc[ai][bj][3][n][j]);
                            *(u32x2*)(vb + (4 * n + j) * 16) = w; }
#pragma unroll
                    for (int m = 0; m < 4; ++m) { const int t = u.pm * 256 + ai * 128 + wr * 64 + m * 16 + fr;
                        if (t >= T_ - 2048) { float* o = outv + (size_t)(t - (T_ - 2048)) * 1024 + h * 128 + d; *(f32x4*)o = acc[ai][bj][m][0]; *(f32x4*)(o + 4) = acc[ai][bj][m][1]; } }
                }
            return;
        }
#pragma unroll
        for (int ai = 0; ai < 2; ++ai)
#pragma unroll
            for (int m = 0; m < 4; ++m) {
                const int t = u.pm * 256 + ai * 128 + wr * 64 + m * 16 + fr;
#pragma unroll
                for (int bj = 0; bj < 2; ++bj) {
                    f32x4 v0 = acc[ai][bj][m][0], v1 = acc[ai][bj][m][1];
                    if (region >= 3) {
                        u32x4 w; w.x = pk2(v0[0], v0[1]); w.y = pk2(v0[2], v0[3]); w.z = pk2(v1[0], v1[1]); w.w = pk2(v1[2], v1[3]);
                        *(u32x4*)(HG + (size_t)t * 4096 + (u.pn - 12) * 256 + bj * 128 + wc * 32 + 8 * fq) = w;
                    } else {
                        const int h = (u.pn & 3) * 2 + bj, d = wc * 32 + 8 * fq, rho = t & 15, uu = t >> 4;
                        if (region == 0) {
                            v0 = v0 * qscale; v1 = v1 * qscale;
                            u32x4 w; w.x = pk2(v0[0], v0[1]); w.y = pk2(v0[2], v0[3]); w.z = pk2(v1[0], v1[1]); w.w = pk2(v1[2], v1[3]);
                            *(u32x4*)(QC + ((size_t)(h * 16 + rho) * 1024 + uu) * 128 + d) = w;
                        } else if (region == 1) {
                            u32x4 w; w.x = pk2(v0[0], v0[1]); w.y = pk2(v0[2], v0[3]); w.z = pk2(v1[0], v1[1]); w.w = pk2(v1[2], v1[3]);
                            *(u32x4*)(KC + ((((size_t)(h * 16 + rho) * 64 + (uu >> 4)) * 4 + wc) * 16 + (uu & 15)) * 32 + 8 * fq) = w;
                            if (t >= T_ - 2048) { float* o = outk + (size_t)(t - (T_ - 2048)) * 1024 + h * 128 + d; *(f32x4*)o = v0; *(f32x4*)(o + 4) = v1; }
                        } else {
                            bf16_t* vb = VT + (((size_t)(h * 16 + rho) * 64 + (uu >> 4)) * 128 + d) * 16 + (uu & 15);
#pragma unroll
                            for (int j = 0; j < 4; ++j) { vb[j * 16] = f2bf(v0[j]); vb[(4 + j) * 16] = f2bf(v1[j]); }
                            if (t >= T_ - 2048) { float* o = outv + (size_t)(t - (T_ - 2048)) * 1024 + h * 128 + d; *(f32x4*)o = v0; *(f32x4*)(o + 4) = v1; }
                        }
                    }
                }
            }
    }
};

#define WS_PTR(type, off) ((type*)(P.ws + (off)))
#define LDS_WAIT() asm volatile("s_waitcnt lgkmcnt(0)" ::: "memory")
#if MK_SETTLE
#define SETTLE() do { __builtin_amdgcn_sched_barrier(0); asm volatile("s_nop 15\n\ts_nop 15"); __builtin_amdgcn_sched_barrier(0); } while (0)
#else
#define SETTLE() do {} while (0)
#endif

__device__ __forceinline__ void transpose_item(const float* W, int K, int N, bf16_t* WT, int grp, int gstride, int goff, float* scr, int item, int lane) {
    const int nblk = N / 32, kb = item / nblk, nb = item % nblk, k0 = 64 * kb, n0 = 32 * nb;
    const int rowbase = (n0 / grp) * gstride + (n0 % grp) + goff;
    float wv[32];
#pragma unroll
    for (int i = 0; i < 32; ++i) wv[i] = __builtin_nontemporal_load(W + (size_t)(k0 + 2 * i + (lane >> 5)) * N + n0 + (lane & 31));
#pragma unroll
    for (int i = 0; i < 32; ++i) scr[(2 * i + (lane >> 5)) * 33 + (lane & 31)] = wv[i];
    LDS_WAIT();
    const int c = lane & 7;
#pragma unroll
    for (int j = 0; j < 4; ++j) { const int n = (lane >> 3) + 8 * j; const float* s = scr + (8 * c) * 33 + n;
        u32x4 o; o.x = pk2(s[0 * 33], s[1 * 33]); o.y = pk2(s[2 * 33], s[3 * 33]); o.z = pk2(s[4 * 33], s[5 * 33]); o.w = pk2(s[6 * 33], s[7 * 33]);
        *(u32x4*)(WT + (size_t)(rowbase + n) * K + k0 + 8 * c) = o; }
    LDS_WAIT();
}
__device__ __forceinline__ void rms_row_bf16(const float* x, const float* g, bf16_t* o, int lane) {
    f32x4 v[8]; float ss = 0.f;
#pragma unroll
    for (int j = 0; j < 8; ++j) { v[j] = ((const f32x4*)x)[lane + 64 * j]; ss += v[j][0] * v[j][0] + v[j][1] * v[j][1] + v[j][2] * v[j][2] + v[j][3] * v[j][3]; }
    const float r = rsqrtf(wave_sum(ss) * (1.f / 2048.f) + EPS_);
#pragma unroll
    for (int j = 0; j < 8; ++j) { const f32x4 gv = ((const f32x4*)g)[lane + 64 * j];
        u32x2 w; w.x = pk2(v[j][0] * r * gv[0], v[j][1] * r * gv[1]); w.y = pk2(v[j][2] * r * gv[2], v[j][3] * r * gv[3]);
        ((u32x2*)o)[lane + 64 * j] = w; }
}
__device__ __forceinline__ f32x4 ld4(const float* p, int i) { return ((const f32x4*)p)[i]; }
__device__ __forceinline__ f32x4 ld4(const bf16_t* p, int i) { const u32x2 w = ((const u32x2*)p)[i]; return (f32x4){bflo(w.x), bfhi(w.x), bflo(w.y), bfhi(w.y)}; }
__device__ __forceinline__ f32x4 ld4nt(const float* p, int i) { return __builtin_nontemporal_load((const f32x4*)p + i); }
__device__ __forceinline__ f32x4 ld4nt(const bf16_t* p, int i) { const u32x2 w = __builtin_nontemporal_load((const u32x2*)p + i); return (f32x4){bflo(w.x), bfhi(w.x), bflo(w.y), bfhi(w.y)}; }
__device__ __forceinline__ void st4nt(float* p, int i, f32x4 v) { __builtin_nontemporal_store(v, (f32x4*)p + i); }
__device__ __forceinline__ void st4(float* p, int i, f32x4 v) { ((f32x4*)p)[i] = v; }
__device__ __forceinline__ void st4(bf16_t* p, int i, f32x4 v) { u32x2 w; w.x = pk2(v[0], v[1]); w.y = pk2(v[2], v[3]); ((u32x2*)p)[i] = w; }
template <class TM, class TX> __device__ __forceinline__ void post_mix_row(const float* x, const TM* mix, const float* g1, const float* g2, TX* x1out, bf16_t* h2, int lane) {
    f32x4 v[8]; float ss = 0.f;
#pragma unroll
    for (int j = 0; j < 8; ++j) { v[j] = ld4(mix, lane + 64 * j); ss += v[j][0] * v[j][0] + v[j][1] * v[j][1] + v[j][2] * v[j][2] + v[j][3] * v[j][3]; }
    const float r = rsqrtf(wave_sum(ss) * (1.f / 2048.f) + EPS_);
    float ss2 = 0.f;
#pragma unroll
    for (int j = 0; j < 8; ++j) { const f32x4 gv = ((const f32x4*)g1)[lane + 64 * j]; const f32x4 xv = ((const f32x4*)x)[lane + 64 * j];
        v[j] = xv + v[j] * r * gv; st4(x1out, lane + 64 * j, v[j]);
        ss2 += v[j][0] * v[j][0] + v[j][1] * v[j][1] + v[j][2] * v[j][2] + v[j][3] * v[j][3]; }
    const float r2 = rsqrtf(wave_sum(ss2) * (1.f / 2048.f) + EPS_);
#pragma unroll
    for (int j = 0; j < 8; ++j) { const f32x4 gv = ((const f32x4*)g2)[lane + 64 * j];
        u32x2 w; w.x = pk2(v[j][0] * r2 * gv[0], v[j][1] * r2 * gv[1]); w.y = pk2(v[j][2] * r2 * gv[2], v[j][3] * r2 * gv[3]);
        ((u32x2*)h2)[lane + 64 * j] = w; }
}
template <class TM, class TX> __device__ __forceinline__ void final_row(const TX* x1, const TM* ffo, const float* g, float* y, int lane) {
    f32x4 v[8]; float ss = 0.f;
#pragma unroll
    for (int j = 0; j < 8; ++j) { v[j] = ld4(ffo, lane + 64 * j); ss += v[j][0] * v[j][0] + v[j][1] * v[j][1] + v[j][2] * v[j][2] + v[j][3] * v[j][3]; }
    const float r = rsqrtf(wave_sum(ss) * (1.f / 2048.f) + EPS_);
#pragma unroll
    for (int j = 0; j < 8; ++j) { const f32x4 gv = ((const f32x4*)g)[lane + 64 * j]; const f32x4 xv = ld4(x1, lane + 64 * j);
        ((f32x4*)y)[lane + 64 * j] = xv + v[j] * r * gv; }
}

__device__ __forceinline__ float sq4(f32x4 v) { return v[0] * v[0] + v[1] * v[1] + v[2] * v[2] + v[3] * v[3]; }
__device__ __forceinline__ void rms_row2_bf16(const float* x, const float* g, bf16_t* o, size_t d2, int lane) {
    f32x4 v[2][8]; float ss[2] = {0.f, 0.f};
#pragma unroll
    for (int rr = 0; rr < 2; ++rr)
#pragma unroll
        for (int j = 0; j < 8; ++j) v[rr][j] = ld4nt(x + rr * d2, lane + 64 * j);
#pragma unroll
    for (int rr = 0; rr < 2; ++rr)
#pragma unroll
        for (int j = 0; j < 8; ++j) ss[rr] += sq4(v[rr][j]);
    const float r0 = rsqrtf(wave_sum(ss[0]) * (1.f / 2048.f) + EPS_), r1 = rsqrtf(wave_sum(ss[1]) * (1.f / 2048.f) + EPS_);
#pragma unroll
    for (int j = 0; j < 8; ++j) { const f32x4 gv = ((const f32x4*)g)[lane + 64 * j];
        st4(o, lane + 64 * j, v[0][j] * r0 * gv); st4(o + d2, lane + 64 * j, v[1][j] * r1 * gv); }
}
template <class TM, class TX> __device__ __forceinline__ void post_mix_row2(const float* x, const TM* mix, const float* g1, const float* g2, TX* x1out, bf16_t* h2, size_t d2, int lane) {
    f32x4 v[2][8], xv[2][8]; float ss[2] = {0.f, 0.f};
#pragma unroll
    for (int rr = 0; rr < 2; ++rr)
#pragma unroll
        for (int j = 0; j < 8; ++j) { v[rr][j] = ld4nt(mix + rr * d2, lane + 64 * j); xv[rr][j] = ld4nt(x + rr * d2, lane + 64 * j); }
#pragma unroll
    for (int rr = 0; rr < 2; ++rr)
#pragma unroll
        for (int j = 0; j < 8; ++j) ss[rr] += sq4(v[rr][j]);
    const float r0 = rsqrtf(wave_sum(ss[0]) * (1.f / 2048.f) + EPS_), r1 = rsqrtf(wave_sum(ss[1]) * (1.f / 2048.f) + EPS_);
    float s2[2] = {0.f, 0.f};
#pragma unroll
    for (int j = 0; j < 8; ++j) { const f32x4 gv = ((const f32x4*)g1)[lane + 64 * j];
        v[0][j] = xv[0][j] + v[0][j] * r0 * gv; v[1][j] = xv[1][j] + v[1][j] * r1 * gv;
        st4(x1out, lane + 64 * j, v[0][j]); st4(x1out + d2, lane + 64 * j, v[1][j]);
        s2[0] += sq4(v[0][j]); s2[1] += sq4(v[1][j]); }
    const float q0 = rsqrtf(wave_sum(s2[0]) * (1.f / 2048.f) + EPS_), q1 = rsqrtf(wave_sum(s2[1]) * (1.f / 2048.f) + EPS_);
#pragma unroll
    for (int j = 0; j < 8; ++j) { const f32x4 gv = ((const f32x4*)g2)[lane + 64 * j];
        st4(h2, lane + 64 * j, v[0][j] * q0 * gv); st4(h2 + d2, lane + 64 * j, v[1][j] * q1 * gv); }
}
template <class TM, class TX> __device__ __forceinline__ void final_row2(const TX* x1, const TM* ffo, const float* g, float* y, size_t d2, int lane) {
    f32x4 v[2][8], xv[2][8]; float ss[2] = {0.f, 0.f};
#pragma unroll
    for (int rr = 0; rr < 2; ++rr)
#pragma unroll
        for (int j = 0; j < 8; ++j) { v[rr][j] = ld4nt(ffo + rr * d2, lane + 64 * j); xv[rr][j] = ld4nt(x1 + rr * d2, lane + 64 * j); }
#pragma unroll
    for (int rr = 0; rr < 2; ++rr)
#pragma unroll
        for (int j = 0; j < 8; ++j) ss[rr] += sq4(v[rr][j]);
    const float r0 = rsqrtf(wave_sum(ss[0]) * (1.f / 2048.f) + EPS_), r1 = rsqrtf(wave_sum(ss[1]) * (1.f / 2048.f) + EPS_);
#pragma unroll
    for (int j = 0; j < 8; ++j) { const f32x4 gv = ((const f32x4*)g)[lane + 64 * j];
        st4nt(y, lane + 64 * j, xv[0][j] + v[0][j] * r0 * gv); st4nt(y + d2, lane + 64 * j, xv[1][j] + v[1][j] * r1 * gv); }
}

template <class F> __device__ __forceinline__ void skinny_gemm(const bf16_t* A, const bf16_t* Bt, int K, int N, float* red, F store, int i0 = -1, int istep = 0) {
    const int tid = threadIdx.x, wave = tid >> 6, lane = tid & 63, r16 = lane & 15, g = lane >> 4;
    if (i0 < 0) { i0 = blockIdx.x; istep = gridDim.x; }
    for (int item = i0; item < N / 16; item += istep) {
        const int n0 = item * 16, kper = K >> 3, kb = wave * kper;
        const bf16_t* a0p = A + (size_t)r16 * K + kb + g * 8; const bf16_t* a1p = a0p + (size_t)16 * K;
        const bf16_t* bp = Bt + (size_t)(n0 + r16) * K + kb + g * 8;
        f32x4 c0 = {0.f, 0.f, 0.f, 0.f}, c1 = {0.f, 0.f, 0.f, 0.f};
#pragma unroll 8
        for (int k = 0; k < kper; k += 32) {
            const s16x8 a0 = *(const s16x8*)(a0p + k), a1 = *(const s16x8*)(a1p + k), b = *(const s16x8*)(bp + k);
            c0 = __builtin_amdgcn_mfma_f32_16x16x32_bf16(a0, b, c0, 0, 0, 0); c1 = __builtin_amdgcn_mfma_f32_16x16x32_bf16(a1, b, c1, 0, 0, 0);
            asm volatile("" : "+v"(c0), "+v"(c1) : "v"(a0), "v"(a1), "v"(b)); }
#pragma unroll
        for (int j = 0; j < 4; ++j) { red[wave * 512 + (g * 4 + j) * 16 + r16] = c0[j]; red[wave * 512 + (16 + g * 4 + j) * 16 + r16] = c1[j]; }
        __syncthreads();
        float s = 0.f;
#pragma unroll
        for (int w = 0; w < 8; ++w) s += red[w * 512 + tid];
        store(tid >> 4, n0 + (tid & 15), s);
        __syncthreads();
    }
}
__device__ __forceinline__ void skinny_gu(const bf16_t* A, const bf16_t* Bt, bf16_t* ffs, float* red) {
    const int tid = threadIdx.x, wave = tid >> 6, lane = tid & 63, r16 = lane & 15, g = lane >> 4;
    constexpr int K = 2048;
    for (int item = blockIdx.x; item < DFF / 16; item += gridDim.x) {
        const int n0 = item * 16, kper = K >> 3, kb = wave * kper;
        const int rowg = (n0 / 128) * 256 + (n0 % 128) + r16;
        const bf16_t* a0p = A + (size_t)r16 * K + kb + g * 8; const bf16_t* a1p = a0p + (size_t)16 * K;
        const bf16_t* bgp = Bt + (size_t)rowg * K + kb + g * 8; const bf16_t* bup = bgp + (size_t)128 * K;
        f32x4 c0 = {0.f, 0.f, 0.f, 0.f}, c1 = c0, c2 = c0, c3 = c0;
#pragma unroll 8
        for (int k = 0; k < kper; k += 32) {
            const s16x8 a0 = *(const s16x8*)(a0p + k), a1 = *(const s16x8*)(a1p + k), bg = *(const s16x8*)(bgp + k), bu = *(const s16x8*)(bup + k);
            c0 = __builtin_amdgcn_mfma_f32_16x16x32_bf16(a0, bg, c0, 0, 0, 0); c1 = __builtin_amdgcn_mfma_f32_16x16x32_bf16(a1, bg, c1, 0, 0, 0);
            c2 = __builtin_amdgcn_mfma_f32_16x16x32_bf16(a0, bu, c2, 0, 0, 0); c3 = __builtin_amdgcn_mfma_f32_16x16x32_bf16(a1, bu, c3, 0, 0, 0);
            asm volatile("" : "+v"(c0), "+v"(c1), "+v"(c2), "+v"(c3) : "v"(a0), "v"(a1), "v"(bg), "v"(bu)); }
#pragma unroll
        for (int j = 0; j < 4; ++j) { red[wave * 1024 + (g * 4 + j) * 16 + r16] = c0[j]; red[wave * 1024 + (16 + g * 4 + j) * 16 + r16] = c1[j];
            red[wave * 1024 + 512 + (g * 4 + j) * 16 + r16] = c2[j]; red[wave * 1024 + 512 + (16 + g * 4 + j) * 16 + r16] = c3[j]; }
        __syncthreads();
        float sg = 0.f, su = 0.f;
#pragma unroll
        for (int w = 0; w < 8; ++w) { sg += red[w * 1024 + tid]; su += red[w * 1024 + 512 + tid]; }
        ffs[(size_t)(tid >> 4) * DFF + n0 + (tid & 15)] = f2bf(siluf_(sg) * su);
        __syncthreads();
    }
}

__device__ __forceinline__ int att_tile0(int r, int rho, int q0) {
    const int delta = r - rho;
    const int hmax = (delta == 0) ? 128 : (((delta & 3) == 0) ? ((512 - delta) >> 4) : ((128 - delta) >> 4));
    const int t0 = (q0 - hmax) >> 4; return t0 < 0 ? 0 : t0;
}
__device__ __forceinline__ void attn_item(const Params& P, int item_, int lane) {
    const int item = __builtin_amdgcn_readfirstlane(item_);
    const int r = item & 15, pm = (item >> 4) & 63, h = item >> 10;
    const int q0 = pm * 16, g = lane >> 4, r16 = lane & 15;
    const bf16_t* QC = WS_PTR(const bf16_t, WS_QC);
    const char* KCu = (const char*)(WS_PTR(const bf16_t, WS_KC) + (size_t)h * 16 * 1024 * 128);
    const char* VTu = (const char*)(WS_PTR(const bf16_t, WS_VT) + (size_t)h * 16 * 128 * 1024);
    const unsigned klane = (unsigned)(r16 * 64 + g * 16), vlane = (unsigned)(r16 * 32 + g * 8);
    s16x8 qf[4];
    { const bf16_t* qb = QC + ((size_t)(h * 16 + r) * 1024 + q0 + r16) * 128 + g * 8;
#pragma unroll
      for (int kk = 0; kk < 4; ++kk) qf[kk] = *(const s16x8*)(qb + 32 * kk); }
    float m_run = -INFINITY, l_run = 0.f;
    f32x4 o[8];
#pragma unroll
    for (int dt = 0; dt < 8; ++dt) o[dt] = (f32x4){0.f, 0.f, 0.f, 0.f};
    int NT = 0;
    for (int rho = 0; rho < 16; ++rho) NT += pm - att_tile0(r, rho, q0) + 1;
#define ATT_LOAD(KF, VF, rho_, tile_) do { \
        const char* kp_ = KCu + (size_t)(((rho_) * 64 + (tile_)) * 4096) + klane; \
        _Pragma("unroll") for (int kk = 0; kk < 4; ++kk) KF[kk] = *(const s16x8*)(kp_ + 1024 * kk); \
        const char* vp_ = VTu + (size_t)(((rho_) * 64 + (tile_)) * 4096) + vlane; \
        _Pragma("unroll") for (int dt = 0; dt < 8; ++dt) VF[dt] = *(const s16x4*)(vp_ + 512 * dt); } while (0)
#define ATT_NEXT(rho_, tile_) do { if (++tile_ > pm) { if (rho_ < 15) { ++rho_; tile_ = att_tile0(r, rho_, q0); } else tile_ = pm; } } while (0)
#define ATT_COMPUTE(KF, VF, rho_, tile_, valid_) do { \
        const int delta = r - (rho_); const int lo = delta < 0 ? 1 : 0; const int h1 = (128 - delta) >> 4; \
        const int h2 = ((delta & 3) == 0) ? ((512 - delta) >> 4) : -1; const int h3 = (delta == 0) ? 128 : -1; \
        f32x4 s = {0.f, 0.f, 0.f, 0.f}; \
        _Pragma("unroll") for (int kk = 0; kk < 4; ++kk) s = __builtin_amdgcn_mfma_f32_16x16x32_bf16(KF[kk], qf[kk], s, 0, 0, 0); \
        asm volatile("" : "+v"(s) : "v"(KF[0]), "v"(KF[1]), "v"(KF[2]), "v"(KF[3])); \
        const int dist = (q0 + r16) - ((tile_) * 16 + 4 * g); \
        const int lo_ = (valid_) ? lo : (1 << 20); \
        float mult[4], sv[4]; float tm = -INFINITY; \
        _Pragma("unroll") for (int i = 0; i < 4; ++i) { const int dd = dist - i; \
            int mu = (int)(dd <= h1) + (int)(dd <= h2) + (int)(dd <= h3); mu = (dd >= lo_) ? mu : 0; \
            mult[i] = (float)mu; sv[i] = (mu > 0) ? s[i] : -INFINITY; tm = fmaxf(tm, sv[i]); } \
        tm = fmaxf(tm, __shfl_xor(tm, 16)); tm = fmaxf(tm, __shfl_xor(tm, 32)); \
        const float m_new = fmaxf(m_run, tm); \
        if (__any(m_new > m_run)) { \
            const float alpha = (m_new == -INFINITY) ? 1.f : __builtin_amdgcn_exp2f(m_run - m_new); \
            l_run *= alpha; \
            _Pragma("unroll") for (int dt = 0; dt < 8; ++dt) o[dt] = o[dt] * alpha; \
            m_run = m_new; } \
        float p[4]; const float m_use = fmaxf(m_run, -1e30f); \
        _Pragma("unroll") for (int i = 0; i < 4; ++i) { p[i] = mult[i] * __builtin_amdgcn_exp2f(sv[i] - m_use); l_run += p[i]; } \
        u32x2 pw; pw.x = pk2(p[0], p[1]); pw.y = pk2(p[2], p[3]); \
        const s16x4 pb = __builtin_bit_cast(s16x4, pw); \
        _Pragma("unroll") for (int dt = 0; dt < 8; ++dt) o[dt] = __builtin_amdgcn_mfma_f32_16x16x16bf16_1k(VF[dt], pb, o[dt], 0, 0, 0); \
        asm volatile("" : "+v"(o[0]), "+v"(o[7]) : "v"(pb), "v"(VF[0]), "v"(VF[1]), "v"(VF[2]), "v"(VF[3]), "v"(VF[4]), "v"(VF[5]), "v"(VF[6]), "v"(VF[7])); } while (0)
    int prho = 0, ptile = att_tile0(r, 0, q0), crho = 0, ctile = ptile;
    s16x8 kfA[4], kfB[4], kfC[4]; s16x4 vfA[8], vfB[8], vfC[8];
    ATT_LOAD(kfA, vfA, prho, ptile); ATT_NEXT(prho, ptile);
    ATT_LOAD(kfB, vfB, prho, ptile); ATT_NEXT(prho, ptile);
    for (int step = 0; step < NT; step += 3) {
        ATT_LOAD(kfC, vfC, prho, ptile); ATT_NEXT(prho, ptile);
        ATT_COMPUTE(kfA, vfA, crho, ctile, true); ATT_NEXT(crho, ctile);
        ATT_LOAD(kfA, vfA, prho, ptile); ATT_NEXT(prho, ptile);
        ATT_COMPUTE(kfB, vfB, crho, ctile, (step + 1 < NT)); ATT_NEXT(crho, ctile);
        ATT_LOAD(kfB, vfB, prho, ptile); ATT_NEXT(prho, ptile);
        ATT_COMPUTE(kfC, vfC, crho, ctile, (step + 2 < NT)); ATT_NEXT(crho, ctile);
    }
#undef ATT_LOAD
#undef ATT_NEXT
#undef ATT_COMPUTE
    float l = l_run; l += __shfl_xor(l, 16); l += __shfl_xor(l, 32);
    const float inv = 1.f / l;
    const int t = 16 * (q0 + r16) + r;
    bf16_t* op = WS_PTR(bf16_t, WS_OATT) + (size_t)t * 1024 + h * 128 + 4 * g;
#pragma unroll
    for (int dt = 0; dt < 8; ++dt) { const f32x4 v = o[dt] * inv;
        u32x2 w; w.x = pk2(v[0], v[1]); w.y = pk2(v[2], v[3]); *(u32x2*)(op + 16 * dt) = w; }
}

__device__ __forceinline__ int samp_dist(int slot) { return slot < 129 ? slot : (slot < 258 ? 4 * (slot - 129) : 16 * (slot - 258)); }
__device__ __forceinline__ void sattn_item(const Params& P, int item, float* lf) {
    const int tid = threadIdx.x, wave = tid >> 6, b = item >> 3, h = item & 7;
    float* qs = lf; float* sc = lf + 128; float* red = lf + 640; float* po = lf + 704;
    const float* proj = WS_PTR(const float, WS_PROJS) + (size_t)b * NIN;
    if (tid < 128) { qs[tid] = proj[h * 128 + tid] * 0.08838834764831845f;
        P.out[O_WKS + b * 1024 + h * 128 + tid] = proj[1024 + h * 128 + tid]; P.out[O_WVS + b * 1024 + h * 128 + tid] = proj[2048 + h * 128 + tid]; }
    __syncthreads();
    const bool valid = tid < 387; const int d = samp_dist(tid);
    float s = -INFINITY;
    if (valid) { const float* kp = (d == 0) ? (proj + 1024 + h * 128) : (P.cache_k + (((size_t)b * PAST + (PAST - d)) * 8 + h) * 128);
        float a = 0.f;
#pragma unroll 16
        for (int j = 0; j < 32; ++j) { const f32x4 kv = ((const f32x4*)kp)[j]; const f32x4 qv = ((const f32x4*)qs)[j]; a += kv[0] * qv[0] + kv[1] * qv[1] + kv[2] * qv[2] + kv[3] * qv[3]; }
        s = a; }
    float m = s;
#pragma unroll
    for (int o = 1; o < 64; o <<= 1) m = fmaxf(m, __shfl_xor(m, o));
    if ((tid & 63) == 0) red[wave] = m;
    __syncthreads();
    m = red[0];
#pragma unroll
    for (int w = 1; w < 8; ++w) m = fmaxf(m, red[w]);
    const float p = valid ? __expf(s - m) : 0.f;
    sc[tid] = p;
    const float ps = wave_sum(p);
    __syncthreads();
    if ((tid & 63) == 0) red[8 + wave] = ps;
    __syncthreads();
    float tot = 0.f;
#pragma unroll
    for (int w = 0; w < 8; ++w) tot += red[8 + w];
    const int dq = tid & 31, kg = tid >> 5; f32x4 acc = {0.f, 0.f, 0.f, 0.f};
#pragma unroll
    for (int it = 0; it < 25; ++it) { const int j = kg + 16 * it;
        if (j < 387) { const int dj = samp_dist(j);
            const float* vp = (dj == 0) ? (proj + 2048 + h * 128) : (P.cache_v + (((size_t)b * PAST + (PAST - dj)) * 8 + h) * 128);
            const f32x4 vv = ((const f32x4*)vp)[dq]; const float pj = sc[j]; acc = acc + vv * pj; } }
    __syncthreads();
    ((f32x4*)po)[kg * 32 + dq] = acc;
    __syncthreads();
    if (tid < 128) { float o = 0.f;
#pragma unroll
        for (int q = 0; q < 16; ++q) o += po[q * 128 + tid];
        WS_PTR(float, WS_OATTS)[b * 1024 + h * 128 + tid] = o / tot; }
    __syncthreads();
}
__device__ __forceinline__ void shgrn_item(const Params& P, int item, float* lf) {
    const int tid = threadIdx.x, wave = tid >> 6, b = item >> 3, h = item & 7;
    float* qv = lf; float* fv = lf + 128; float* kv = lf + 256; float* po = lf + 384; float* red = lf + 896;
    const float* proj = WS_PTR(const float, WS_PROJS) + (size_t)b * NIN;
    if (tid < 128) { const int idx = h * 128 + tid; const float l0 = P.lb_logits[idx], l1 = P.lb_logits[1024 + idx];
        const float lbv = 1.f / (1.f + __expf(l1 - l0)); const float x = proj[4096 + idx];
        fv[tid] = lbv + (1.f - lbv) * sigmoidf_(x); kv[tid] = (1.f - lbv) * sigmoidf_(-x); qv[tid] = siluf_(proj[3072 + idx]); }
    __syncthreads();
    const int v = tid & 127, grp = tid >> 7; const float vv = proj[5120 + h * 128 + v]; float acc = 0.f;
    const size_t sb = ((size_t)(b * 8 + h) * 128) * 128;
#pragma unroll 16
    for (int k = grp * 32; k < grp * 32 + 32; ++k) { const float s = fv[k] * __builtin_nontemporal_load(P.state_in + sb + (size_t)k * 128 + v) + kv[k] * vv; __builtin_nontemporal_store(s, P.out + O_STS + sb + (size_t)k * 128 + v); acc += qv[k] * s; }
    po[tid] = acc;
    __syncthreads();
    float o = 0.f;
    if (tid < 128) { o = po[tid] + po[tid + 128] + po[tid + 256] + po[tid + 384]; const float ss = wave_sum(o * o); if ((tid & 63) == 0) red[wave] = ss; }
    __syncthreads();
    if (tid < 128) { const float rstd = rsqrtf((red[0] + red[1]) * (1.f / 128.f) + EPS_);
        WS_PTR(float, WS_OHGS)[b * 1024 + h * 128 + tid] = o * rstd * P.hg_gain[tid] * siluf_(proj[6144 + h * 128 + tid]); }
    __syncthreads();
}

template <bool OUT> __device__ __forceinline__ void hgrn_item(const Params& P, int item, unsigned char* lds) {
    const int tid = threadIdx.x, wave = tid >> 6, lane = tid & 63, g = lane >> 4, r16 = lane & 15;
    const int h = item / NCH, c = item % NCH;
    bf16_t* Qs = (bf16_t*)lds; bf16_t* Ks = (bf16_t*)(lds + 17408); bf16_t* KHt = (bf16_t*)(lds + 34816); bf16_t* Vt = (bf16_t*)(lds + 51200);
    float* Ds = (float*)(lds + 67584); float* Os = (float*)(lds + 69632);
    const bf16_t* HG = WS_PTR(const bf16_t, WS_HG);
    f32x4 S[8];
    float* Ub = WS_PTR(float, WS_U) + ((size_t)(c * 8 + h) * 128) * 128 + 16 * wave + r16;
#pragma unroll
    for (int kt = 0; kt < 8; ++kt) {
        if (OUT && MK_VAR != 1) {
#pragma unroll
            for (int i = 0; i < 4; ++i) S[kt][i] = Ub[(size_t)(16 * kt + 4 * g + i) * 128];
        } else S[kt] = (f32x4){0.f, 0.f, 0.f, 0.f};
    }
    float dtot = 1.f;
    unsigned short fx[16], vx[16], qx[16];
#define HG_LOADS(t0_) do { const bf16_t* hg_ = HG + (size_t)((t0_) + (tid >> 7) * 16) * 4096 + h * 128 + (tid & 127); \
        _Pragma("unroll") for (int t = 0; t < 16; ++t) { \
            if (OUT) { fx[t] = __builtin_nontemporal_load(hg_ + (size_t)t * 4096 + 1024); vx[t] = __builtin_nontemporal_load(hg_ + (size_t)t * 4096 + 2048); qx[t] = __builtin_nontemporal_load(hg_ + (size_t)t * 4096); } \
            else { fx[t] = hg_[(size_t)t * 4096 + 1024]; vx[t] = hg_[(size_t)t * 4096 + 2048]; } } } while (0)
    HG_LOADS(c * 256);
    f32x4 gnv[4];
    if (OUT) {
#pragma unroll
        for (int q = 0; q < 4; ++q) gnv[q] = ((const f32x4*)(P.hg_gain + 16 * (tid & 7)))[q]; }
    for (int sc = 0; sc < 4; ++sc) {
    const int t0 = c * 256 + sc * 64;
    u32x4 ga = {0u, 0u, 0u, 0u}, gb = ga;
    if (OUT) { const u32x4* gp = (const u32x4*)(HG + (size_t)(t0 + (tid >> 3)) * 4096 + 3072 + h * 128 + 16 * (tid & 7)); ga = gp[0]; gb = gp[1]; }
    {
        const int k = tid & 127, sb = tid >> 7;
        const float l0 = P.lb_logits[h * 128 + k], l1 = P.lb_logits[1024 + h * 128 + k];
        const float lbk = __builtin_amdgcn_rcpf(1.f + __expf(l1 - l0));
        float fv_[16], kvv[16], Pt[16]; float run = 1.f;
#pragma unroll
        for (int t = 0; t < 16; ++t) { const float x = bf2f(fx[t]); const float sg = __builtin_amdgcn_rcpf(1.f + __expf(-x));
            fv_[t] = lbk + (1.f - lbk) * sg; kvv[t] = (1.f - lbk) * (1.f - sg); run *= fv_[t]; Pt[t] = run; }
        float khat[16]; float sfx = 1.f;
#pragma unroll
        for (int t = 15; t >= 0; --t) { khat[t] = kvv[t] * sfx; sfx *= fv_[t]; }
        unsigned khp[8], vtp[8];
#pragma unroll
        for (int t = 0; t < 16; t += 2) {
            if (OUT) {
                const float qa = siluf_(bf2f(qx[t])), qb = siluf_(bf2f(qx[t + 1]));
                Qs[(sb * 16 + t) * 136 + k] = f2bf(qa * Pt[t]); Qs[(sb * 16 + t + 1) * 136 + k] = f2bf(qb * Pt[t + 1]);
                Ks[(sb * 16 + t) * 136 + k] = f2bf(kvv[t] * __builtin_amdgcn_rcpf(Pt[t])); Ks[(sb * 16 + t + 1) * 136 + k] = f2bf(kvv[t + 1] * __builtin_amdgcn_rcpf(Pt[t + 1]));
            }
            khp[t >> 1] = pk2(khat[t], khat[t + 1]);
            vtp[t >> 1] = (unsigned)vx[t] | ((unsigned)vx[t + 1] << 16);
        }
        u32x4* kd = (u32x4*)(KHt + (sb * 128 + k) * 16); kd[0] = (u32x4){khp[0], khp[1], khp[2], khp[3]}; kd[1] = (u32x4){khp[4], khp[5], khp[6], khp[7]};
        u32x4* vd = (u32x4*)(Vt + (sb * 128 + k) * 16); vd[0] = (u32x4){vtp[0], vtp[1], vtp[2], vtp[3]}; vd[1] = (u32x4){vtp[4], vtp[5], vtp[6], vtp[7]};
        Ds[sb * 128 + k] = run;
    }
    __syncthreads();
    if (sc < 3) HG_LOADS(t0 + 64);
    float gg[16];
    if (OUT) {
        const unsigned gw[8] = {ga.x, ga.y, ga.z, ga.w, gb.x, gb.y, gb.z, gb.w};
#pragma unroll
        for (int q = 0; q < 4; ++q) { const f32x4 gn = gnv[q];
            gg[4 * q] = gn[0] * siluf_(bflo(gw[2 * q])); gg[4 * q + 1] = gn[1] * siluf_(bfhi(gw[2 * q]));
            gg[4 * q + 2] = gn[2] * siluf_(bflo(gw[2 * q + 1])); gg[4 * q + 3] = gn[3] * siluf_(bfhi(gw[2 * q + 1])); } }
    for (int sb = 0; sb < 4; ++sb) {
        const s16x4 vA = *(const s16x4*)(Vt + (sb * 128 + 16 * wave + r16) * 16 + 4 * g);
        if (OUT) {
            s16x8 qB[4], kA[4];
#pragma unroll
            for (int kk = 0; kk < 4; ++kk) {
                const s16x4 ql = *(const s16x4*)(Qs + (sb * 16 + r16) * 136 + 32 * kk + 4 * g), qh = *(const s16x4*)(Qs + (sb * 16 + r16) * 136 + 32 * kk + 16 + 4 * g);
                qB[kk] = __builtin_shufflevector(ql, qh, 0, 1, 2, 3, 4, 5, 6, 7);
                const s16x4 kl = *(const s16x4*)(Ks + (sb * 16 + r16) * 136 + 32 * kk + 4 * g), kh = *(const s16x4*)(Ks + (sb * 16 + r16) * 136 + 32 * kk + 16 + 4 * g);
                kA[kk] = __builtin_shufflevector(kl, kh, 0, 1, 2, 3, 4, 5, 6, 7);
            }
            f32x4 oT = {0.f, 0.f, 0.f, 0.f}, aT = {0.f, 0.f, 0.f, 0.f};
#pragma unroll
            for (int kk = 0; kk < 4; ++kk) {
                u32x4 sw; sw.x = pk2(S[2 * kk][0], S[2 * kk][1]); sw.y = pk2(S[2 * kk][2], S[2 * kk][3]); sw.z = pk2(S[2 * kk + 1][0], S[2 * kk + 1][1]); sw.w = pk2(S[2 * kk + 1][2], S[2 * kk + 1][3]);
                const s16x8 sA = __builtin_bit_cast(s16x8, sw);
                oT = __builtin_amdgcn_mfma_f32_16x16x32_bf16(sA, qB[kk], oT, 0, 0, 0);
                aT = __builtin_amdgcn_mfma_f32_16x16x32_bf16(kA[kk], qB[kk], aT, 0, 0, 0);
                asm volatile("" : "+v"(oT), "+v"(aT) : "v"(sA), "v"(qB[kk]), "v"(kA[kk]));
            }
            SETTLE();
#pragma unroll
            for (int i = 0; i < 4; ++i) if (4 * g + i > r16) aT[i] = 0.f;
            u32x2 aw; aw.x = pk2(aT[0], aT[1]); aw.y = pk2(aT[2], aT[3]);
#if MK_SUB != 1
            { const s16x4 aB = __builtin_bit_cast(s16x4, aw);
              oT = __builtin_amdgcn_mfma_f32_16x16x16bf16_1k(vA, aB, oT, 0, 0, 0);
              asm volatile("" : "+v"(oT) : "v"(vA), "v"(aB)); }
#else
            if (aw.x == 0x12345678u && aw.y == 0x9abcdef1u) oT[0] += 1.f;
#endif
            SETTLE();
            *(f32x4*)(Os + (sb * 16 + r16) * 132 + 16 * wave + 4 * g) = oT;
#if MK_VAR == 4
            { u32x2 w; w.x = pk2(oT[0], oT[1]); w.y = pk2(oT[2], oT[3]);
              *(u32x2*)(WS_PTR(bf16_t, WS_MRG) + (size_t)(t0 + sb * 16 + r16) * 2048 + 1024 + h * 128 + 16 * wave + 4 * g) = w; }
#endif
        }
#pragma unroll
        for (int kt = 0; kt < 8; ++kt) {
            const f32x4 d4 = *(const f32x4*)(Ds + sb * 128 + 16 * kt + 4 * g);
            const s16x4 khA = *(const s16x4*)(KHt + (sb * 128 + 16 * kt + r16) * 16 + 4 * g);
            S[kt] = __builtin_amdgcn_mfma_f32_16x16x16bf16_1k(khA, vA, S[kt] * d4, 0, 0, 0);
            asm volatile("" : "+v"(S[kt]) : "v"(khA), "v"(vA));
        }
        SETTLE();
    }
    if (!OUT) {
        if (tid < 128) dtot *= Ds[tid] * Ds[128 + tid] * Ds[256 + tid] * Ds[384 + tid];
    } else {
        __syncthreads();
        const int t = tid >> 3, j = tid & 7;
        const float* orow = Os + t * 132 + 16 * j;
        f32x4 ov[4]; float ss = 0.f;
#pragma unroll
        for (int q = 0; q < 4; ++q) { ov[q] = ((const f32x4*)orow)[q]; ss += ov[q][0] * ov[q][0] + ov[q][1] * ov[q][1] + ov[q][2] * ov[q][2] + ov[q][3] * ov[q][3]; }
        ss += __shfl_xor(ss, 1); ss += __shfl_xor(ss, 2); ss += __shfl_xor(ss, 4);
        const float rstd = rsqrtf(ss * (1.f / 128.f) + EPS_);
        unsigned ow[8];
#pragma unroll
        for (int q = 0; q < 4; ++q) {
            const float a0 = ov[q][0] * rstd * gg[4 * q], a1 = ov[q][1] * rstd * gg[4 * q + 1];
            const float a2 = ov[q][2] * rstd * gg[4 * q + 2], a3 = ov[q][3] * rstd * gg[4 * q + 3];
            ow[2 * q] = pk2(a0, a1); ow[2 * q + 1] = pk2(a2, a3); }
        u32x4* mp = (u32x4*)(WS_PTR(bf16_t, WS_MRG) + (size_t)(t0 + t) * 2048 + 1024 + h * 128 + 16 * j);
#if MK_VAR != 4
        mp[0] = (u32x4){ow[0], ow[1], ow[2], ow[3]}; mp[1] = (u32x4){ow[4], ow[5], ow[6], ow[7]};
#else
        if (ow[0] == 0x12345678u && ow[7] == 0x9abcdef0u) mp[0] = (u32x4){ow[0], ow[1], ow[2], ow[3]};
#endif
    }
    __syncthreads();
    }
#undef HG_LOADS
    if (!OUT) {
#pragma unroll
        for (int kt = 0; kt < 8; ++kt)
#pragma unroll
            for (int i = 0; i < 4; ++i) Ub[(size_t)(16 * kt + 4 * g + i) * 128] = S[kt][i];
        if (tid < 128) WS_PTR(float, WS_DD)[(size_t)(c * 8 + h) * 128 + tid] = dtot;
    }
}

__device__ __forceinline__ void gemm_stagger(int ticks) {
#if MK_STAG
    if ((xb_xcc_id() & 1u) && ticks > 0) { const unsigned long long t0 = __builtin_amdgcn_s_memrealtime(); while ((long long)(__builtin_amdgcn_s_memrealtime() - t0) < ticks) __builtin_amdgcn_s_sleep(8); }
#endif
}
__device__ __forceinline__ void phase_run(const Params& P, int ph, unsigned char* lds) {
    const int tid = threadIdx.x, wave = __builtin_amdgcn_readfirstlane(tid >> 6), lane = tid & 63;
    const int gw = blockIdx.x * 8 + wave, NGW = gridDim.x * 8;
    float* lf = (float*)lds;
    pg8::StaticOrder SO;
#ifdef ONLY_PH
    if (ph != ONLY_PH) return; ph = ONLY_PH;
#endif
    switch (ph) {
    case 0: {
        float* scr = (float*)(lds + wave * 8448);
        constexpr int I_IN = 32 * 224, I_OUT = 32 * 64, I_G = 32 * 176, I_D = 88 * 64;
        for (int it = gw; it < I_IN + I_OUT + 2 * I_G + I_D; it += NGW) {
            int r = it;
            if (r < I_G) { transpose_item(P.w_gate, 2048, DFF, WS_PTR(bf16_t, WS_WGU), 128, 256, 0, scr, r, lane); continue; } r -= I_G;
            if (r < I_G) { transpose_item(P.w_up, 2048, DFF, WS_PTR(bf16_t, WS_WGU), 128, 256, 128, scr, r, lane); continue; } r -= I_G;
            if (r < I_D) { transpose_item(P.w_down, DFF, 2048, WS_PTR(bf16_t, WS_WD), 1 << 20, 0, 0, scr, r, lane); continue; } r -= I_D;
            if (r < I_OUT) { transpose_item(P.w_out, 2048, 2048, WS_PTR(bf16_t, WS_WOUT), 1 << 20, 0, 0, scr, r, lane); continue; } r -= I_OUT;
            transpose_item(P.w_in, 2048, NIN, WS_PTR(bf16_t, WS_WIN), 1 << 20, 0, 0, scr, r, lane);
        }
        { int row = gw;
          for (; row + NGW < T_; row += 2 * NGW) rms_row2_bf16(P.x_prompt + (size_t)row * 2048, P.n_pre_mix, WS_PTR(bf16_t, WS_H) + (size_t)row * 2048, (size_t)NGW * 2048, lane);
          for (; row < T_ + NBS; row += NGW) {
            if (row < T_) rms_row_bf16(P.x_prompt + (size_t)row * 2048, P.n_pre_mix, WS_PTR(bf16_t, WS_H) + (size_t)row * 2048, lane);
            else rms_row_bf16(P.x_sample + (size_t)(row - T_) * 2048, P.n_pre_mix, WS_PTR(bf16_t, WS_HS) + (size_t)(row - T_) * 2048, lane);
          } }
    } break;
    case 1: {
        float* projs = WS_PTR(float, WS_PROJS);
        { int i0 = -1, istep = 0;
          if (gridDim.x == 256) { const int x = blockIdx.x & 7, j = blockIdx.x >> 3;
              if (x < 6) { i0 = j * 6 + x; istep = 192; if (i0 + 192 >= 384) {} } else { i0 = 384 + j * 2 + (x - 6); istep = 1 << 20; } }
          if (gridDim.x == 256 && (blockIdx.x & 7) < 6) {
              skinny_gemm(WS_PTR(const bf16_t, WS_HS), WS_PTR(const bf16_t, WS_WIN), 2048, 384 * 16, lf, [=](int row, int col, float v) { projs[(size_t)row * NIN + col] = v; }, i0, istep);
          } else
              skinny_gemm(WS_PTR(const bf16_t, WS_HS), WS_PTR(const bf16_t, WS_WIN), 2048, NIN, lf, [=](int row, int col, float v) { projs[(size_t)row * NIN + col] = v; }, i0, istep); }
        pg8::Gemm gm{WS_PTR(const bf16_t, WS_H), WS_PTR(const bf16_t, WS_WIN), T_, NIN, 2048};
        SO.init(T_, NIN, (int)gridDim.x, (int)blockIdx.x);
        EpiIn E{WS_PTR(bf16_t, WS_QC), WS_PTR(bf16_t, WS_KC), WS_PTR(bf16_t, WS_VT), WS_PTR(bf16_t, WS_HG), P.out + O_WKP, P.out + O_WVP, 0.08838834764831845f * 1.4426950408889634f};
        gemm_stagger(800);
        RotOrder RO; RO.init(T_, NIN, (int)gridDim.x, (int)blockIdx.x);
        pg8::gemm_phase<EpiIn, RotOrder, false>((PG8_LAS unsigned char*)lds, gm, RO, E, nullptr);
    } break;
    case 2: {
        if ((gridDim.x & 7) == 0) {
            const int hh = blockIdx.x & 7, lw = (blockIdx.x >> 3) * 8 + wave, nlw = gridDim.x;
            for (int j = lw; j < 1024; j += nlw) attn_item(P, hh * 1024 + j, lane);
        } else {
            for (int it = gw; it < 8192; it += NGW) attn_item(P, it, lane);
        }
        __syncthreads();
        for (int it = blockIdx.x; it < 256; it += gridDim.x) { sattn_item(P, it, lf); shgrn_item(P, it, lf); }
        for (int it = blockIdx.x; it < 8 * NCH; it += gridDim.x) hgrn_item<false>(P, it, lds);
    } break;
    case 3: {
        float* U = WS_PTR(float, WS_U); const float* DD = WS_PTR(const float, WS_DD);
        for (int e = blockIdx.x * 512 + tid; e < 8 * 128 * 128; e += gridDim.x * 512) {
            const int hk = e >> 7; float S = 0.f;
#pragma unroll 32
            for (int c = 0; c < NCH; ++c) { const float u = U[(size_t)c * 131072 + e]; const float d = DD[c * 1024 + hk]; U[(size_t)c * 131072 + e] = S; S = d * S + u; }
            P.out[O_STP + e] = S;
        }
        if (gw < NBS) {
            const float* oa = WS_PTR(const float, WS_OATTS) + gw * 1024; const float* oh = WS_PTR(const float, WS_OHGS) + gw * 1024; bf16_t* mr = WS_PTR(bf16_t, WS_MRGS) + gw * 2048;
            f32x4 v[4]; float ss = 0.f;
#pragma unroll
            for (int j = 0; j < 4; ++j) { v[j] = ((const f32x4*)oa)[lane + 64 * j]; ss += v[j][0] * v[j][0] + v[j][1] * v[j][1] + v[j][2] * v[j][2] + v[j][3] * v[j][3]; }
            const float r = rsqrtf(wave_sum(ss) * (1.f / 1024.f) + EPS_);
#pragma unroll
            for (int j = 0; j < 4; ++j) { const f32x4 gv = ((const f32x4*)P.attn_gain)[lane + 64 * j]; const f32x4 hv = ((const f32x4*)oh)[lane + 64 * j];
                u32x2 w; w.x = pk2(v[j][0] * r * gv[0], v[j][1] * r * gv[1]); w.y = pk2(v[j][2] * r * gv[2], v[j][3] * r * gv[3]); ((u32x2*)mr)[lane + 64 * j] = w;
                u32x2 w2; w2.x = pk2(hv[0], hv[1]); w2.y = pk2(hv[2], hv[3]); ((u32x2*)(mr + 1024))[lane + 64 * j] = w2; }
        }
    } break;
    case 4: {
        float* mixs = WS_PTR(float, WS_MIXS);
        skinny_gemm(WS_PTR(const bf16_t, WS_MRGS), WS_PTR(const bf16_t, WS_WOUT), 2048, 2048, lf, [=](int row, int col, float v) { mixs[(size_t)row * 2048 + col] = v; });
        for (int it = blockIdx.x; it < 8 * NCH; it += gridDim.x) hgrn_item<true>(P, it, lds);
        for (int row0 = gw; row0 < T_; row0 += 4 * NGW) {
            u32x4 w[4][2]; float ss[4];
#pragma unroll
            for (int q4 = 0; q4 < 4; ++q4) { const int row = row0 + q4 * NGW; const int rr = row < T_ ? row : row0;
                const u32x4* ip = (const u32x4*)(WS_PTR(const bf16_t, WS_OATT) + (size_t)rr * 1024) + lane * 2; w[q4][0] = ip[0]; w[q4][1] = ip[1]; }
#pragma unroll
            for (int q4 = 0; q4 < 4; ++q4) { float a = 0.f;
#pragma unroll
                for (int q = 0; q < 2; ++q) { const u32x4 v = w[q4][q];
                    a += bflo(v.x) * bflo(v.x) + bfhi(v.x) * bfhi(v.x) + bflo(v.y) * bflo(v.y) + bfhi(v.y) * bfhi(v.y) + bflo(v.z) * bflo(v.z) + bfhi(v.z) * bfhi(v.z) + bflo(v.w) * bflo(v.w) + bfhi(v.w) * bfhi(v.w); }
                ss[q4] = a; }
#pragma unroll
            for (int q4 = 0; q4 < 4; ++q4) ss[q4] = rsqrtf(wave_sum(ss[q4]) * (1.f / 1024.f) + EPS_);
#pragma unroll
            for (int q4 = 0; q4 < 4; ++q4) { const int row = row0 + q4 * NGW; if (row >= T_) break; const float r = ss[q4];
                u32x4* op = (u32x4*)(WS_PTR(bf16_t, WS_MRG) + (size_t)row * 2048) + lane * 2;
#pragma unroll
                for (int q = 0; q < 2; ++q) { const u32x4 v = w[q4][q]; const f32x4 g0 = ((const f32x4*)P.attn_gain)[lane * 4 + q * 2], g1 = ((const f32x4*)P.attn_gain)[lane * 4 + q * 2 + 1];
                    u32x4 o; o.x = pk2(bflo(v.x) * r * g0[0], bfhi(v.x) * r * g0[1]); o.y = pk2(bflo(v.y) * r * g0[2], bfhi(v.y) * r * g0[3]);
                    o.z = pk2(bflo(v.z) * r * g1[0], bfhi(v.z) * r * g1[1]); o.w = pk2(bflo(v.w) * r * g1[2], bfhi(v.w) * r * g1[3]); op[q] = o; } }
        }
    } break;
    case 5: {
        if (gw < NBS) post_mix_row(P.x_sample + (size_t)gw * 2048, WS_PTR(const float, WS_MIXS) + (size_t)gw * 2048, P.n_post_mix, P.n_pre_ffn, P.out + O_YS + (size_t)gw * 2048, WS_PTR(bf16_t, WS_H2S) + (size_t)gw * 2048, lane);
        pg8::Gemm gm{WS_PTR(const bf16_t, WS_MRG), WS_PTR(const bf16_t, WS_WOUT), T_, 2048, 2048};
        SO.init(T_, 2048, (int)gridDim.x, (int)blockIdx.x);
        EpiBf16P E{WS_PTR(bf16_t, WS_MIX), 2048};
        gemm_stagger(800);
        pg8::gemm_phase<EpiBf16P, pg8::StaticOrder, false>((PG8_LAS unsigned char*)lds, gm, SO, E, nullptr);
    } break;
    case 6: {
        skinny_gu(WS_PTR(const bf16_t, WS_H2S), WS_PTR(const bf16_t, WS_WGU), WS_PTR(bf16_t, WS_FFS), lf);
#if MK_DBG == 1
        for (int row = gw; row < T_; row += NGW) for (int c = lane; c < 2048; c += 64) P.out[O_YP + (size_t)row * 2048 + c] = bf2f(WS_PTR(const bf16_t, WS_MRG)[(size_t)row * 2048 + c]);
#elif MK_DBG == 4
        for (int row = gw; row < T_; row += NGW) for (int c = lane; c < 2048; c += 64) P.out[O_YP + (size_t)row * 2048 + c] = bf2f(WS_PTR(const bf16_t, WS_HG)[(size_t)row * 4096 + c]);
#elif MK_DBG == 5
        for (int row = gw; row < T_; row += NGW) for (int c = lane; c < 2048; c += 64) P.out[O_YP + (size_t)row * 2048 + c] = (c >= 1024) ? 0.f : bf2f(WS_PTR(const bf16_t, WS_OATT)[(size_t)row * 1024 + c]);
#elif MK_DBG == 6
        for (size_t i = (size_t)blockIdx.x * 512 + tid; i < (size_t)T_ * 2048; i += (size_t)gridDim.x * 512) P.out[O_YP + i] = WS_PTR(const float, WS_U)[i];
#elif MK_DBG == 7
        for (int row = gw; row < T_; row += NGW) for (int c = lane; c < 2048; c += 64) P.out[O_YP + (size_t)row * 2048 + c] = bf2f(WS_PTR(const bf16_t, WS_HG)[(size_t)row * 4096 + 2048 + c]);
#elif MK_DBG == 2
        for (int row = gw; row < T_; row += NGW) for (int c = lane; c < 2048; c += 64) P.out[O_YP + (size_t)row * 2048 + c] = (c < 1024) ? 0.f : bf2f(WS_PTR(const bf16_t, WS_MRG)[(size_t)row * 2048 + c]);
#else
        { int row = gw;
          for (; row + NGW < T_; row += 2 * NGW)
            post_mix_row2(P.x_prompt + (size_t)row * 2048, WS_PTR(const bf16_t, WS_MIX) + (size_t)row * 2048, P.n_post_mix, P.n_pre_ffn, WS_PTR(bf16_t, WS_MRG) + (size_t)row * 2048, WS_PTR(bf16_t, WS_H) + (size_t)row * 2048, (size_t)NGW * 2048, lane);
          for (; row < T_; row += NGW)
            post_mix_row(P.x_prompt + (size_t)row * 2048, WS_PTR(const bf16_t, WS_MIX) + (size_t)row * 2048, P.n_post_mix, P.n_pre_ffn, WS_PTR(bf16_t, WS_MRG) + (size_t)row * 2048, WS_PTR(bf16_t, WS_H) + (size_t)row * 2048, lane); }
#endif
    } break;
    case 7: {
        float* ffos = WS_PTR(float, WS_FFOS);
        { int i0 = -1, istep = 0;
          if (gridDim.x == 256) { const int x = blockIdx.x & 7, j = blockIdx.x >> 3; i0 = (x < 4) ? (j * 4 + x) : (1 << 20); istep = 1 << 20; }
          skinny_gemm(WS_PTR(const bf16_t, WS_FFS), WS_PTR(const bf16_t, WS_WD), DFF, 2048, lf, [=](int row, int col, float v) { ffos[(size_t)row * 2048 + col] = v; }, i0, istep); }
        pg8::Gemm gm{WS_PTR(const bf16_t, WS_H), WS_PTR(const bf16_t, WS_WGU), T_, 2 * DFF, 2048};
        SO.init(T_, 2 * DFF, (int)gridDim.x, (int)blockIdx.x);
        EpiSwiGLU E{WS_PTR(bf16_t, WS_FF)};
        gemm_stagger(500);
        pg8::gemm_phase<EpiSwiGLU, pg8::StaticOrder, false>((PG8_LAS unsigned char*)lds, gm, SO, E, nullptr);
    } break;
    case 8: {
        if (gw < NBS) final_row(P.out + O_YS + (size_t)gw * 2048, WS_PTR(const float, WS_FFOS) + (size_t)gw * 2048, P.n_post_ffn, P.out + O_YS + (size_t)gw * 2048, lane);
        pg8::Gemm gm{WS_PTR(const bf16_t, WS_FF), WS_PTR(const bf16_t, WS_WD), T_, 2048, DFF};
        SO.init(T_, 2048, (int)gridDim.x, (int)blockIdx.x);
        EpiBf16P E{WS_PTR(bf16_t, WS_MIX), 2048};
        gemm_stagger(800);
        pg8::gemm_phase<EpiBf16P, pg8::StaticOrder, false>((PG8_LAS unsigned char*)lds, gm, SO, E, nullptr);
    } break;
    case 9: {
        { int row = gw;
          for (; row + NGW < T_; row += 2 * NGW)
            final_row2(WS_PTR(const bf16_t, WS_MRG) + (size_t)row * 2048, WS_PTR(const bf16_t, WS_MIX) + (size_t)row * 2048, P.n_post_ffn, P.out + O_YP + (size_t)row * 2048, (size_t)NGW * 2048, lane);
          for (; row < T_; row += NGW)
            final_row(WS_PTR(const bf16_t, WS_MRG) + (size_t)row * 2048, WS_PTR(const bf16_t, WS_MIX) + (size_t)row * 2048, P.n_post_ffn, P.out + O_YP + (size_t)row * 2048, lane); }
    } break;
    default: break;
    }
}

__global__ __launch_bounds__(512, 2) void hymba_fwd(Params P) {
    extern __shared__ __attribute__((aligned(16))) unsigned char shm[];
    cg::grid_group grid = cg::this_grid();
#ifdef TEST_NOLOOP
    phase_run(P, ONLY_PH, shm);
#else
    volatile LAS unsigned* xst = (volatile LAS unsigned*)(shm + 131072);
    if (threadIdx.x < 4) xst[threadIdx.x] = 0u;
    __syncthreads();
    XcdBarrier xb = xcd_barrier_post((unsigned*)(P.ws + WS_BAR), xst);
#if MK_TIMER
    unsigned long long tsv[11]; tsv[0] = __builtin_amdgcn_s_memrealtime();
#define RUN_PH(n) if (P.ph_lo <= n && n < P.ph_hi) { phase_run(P, n, shm); grid.sync(); tsv[n + 1] = __builtin_amdgcn_s_memrealtime(); }
#else
#define RUN_PH(n) if (P.ph_lo <= n && n < P.ph_hi) { phase_run(P, n, shm); if (n + 1 < P.ph_hi) { if (n == MK_CGSEAM) grid.sync(); else xcd_barrier(xb); } }
#endif
    RUN_PH(0) RUN_PH(1) RUN_PH(2) RUN_PH(3) RUN_PH(4) RUN_PH(5) RUN_PH(6) RUN_PH(7) RUN_PH(8) RUN_PH(9)
#if MK_XSYNC
    for (int i = 0; i < MK_XSYNC; ++i) grid.sync();
#endif
    if (P.ph_hi > 1000) grid.sync();
#if MK_TIMER
    if (blockIdx.x == 0) {
        float d[10];
#pragma unroll
        for (int i = 0; i < 10; ++i) d[i] = (float)(tsv[i + 1] - tsv[i]) * 0.01f;
        const float* tw = WS_PTR(const float, WS_SSQ); (void)tw;
        const float T1 = MK_T1, T2 = MK_T2;
        if (threadIdx.x == 0) P.out[O_YS] += T1 * 0.01f;
        for (int i = threadIdx.x; i < 32768; i += 512) P.out[O_WKS + i] += T2 * 0.001f;
    }
#endif
#endif
}

extern "C" void kernel_launch(void* const* d_in, const int* in_sizes, int n_in, void* d_out, int out_size, void* d_ws, size_t ws_size, hipStream_t stream) {
    static int grid = 0;
    if (grid == 0) {
        if (ws_size < WS_END) { fprintf(stderr, "kernel_launch: workspace too small (%zu < %zu)\n", ws_size, (size_t)WS_END); grid = -1; return; }
        int dev = 0, cus = 0, per_cu = 0;
        hipGetDevice(&dev);
        hipDeviceGetAttribute(&cus, hipDeviceAttributeMultiprocessorCount, dev);
        if (hipFuncSetAttribute((const void*)hymba_fwd, hipFuncAttributeMaxDynamicSharedMemorySize, LDS_BYTES) != hipSuccess) { fprintf(stderr, "kernel_launch: hipFuncSetAttribute failed\n"); grid = -1; return; }
        if (hipOccupancyMaxActiveBlocksPerMultiprocessor(&per_cu, (const void*)hymba_fwd, 512, LDS_BYTES) != hipSuccess || per_cu < 1) { fprintf(stderr, "kernel_launch: occupancy query says %d\n", per_cu); per_cu = 1; }
        (void)hipGetLastError();
        grid = cus;
    }
    if (grid < 0) return;
    Params p{};
    p.x_prompt = (const float*)d_in[0]; p.x_sample = (const float*)d_in[1]; p.cache_k = (const float*)d_in[2]; p.cache_v = (const float*)d_in[3]; p.state_in = (const float*)d_in[4];
    p.n_pre_mix = (const float*)d_in[5]; p.w_in = (const float*)d_in[6]; p.lb_logits = (const float*)d_in[7]; p.attn_gain = (const float*)d_in[8]; p.hg_gain = (const float*)d_in[9];
    p.w_out = (const float*)d_in[10]; p.n_post_mix = (const float*)d_in[11]; p.n_pre_ffn = (const float*)d_in[12]; p.w_gate = (const float*)d_in[13]; p.w_up = (const float*)d_in[14];
    p.w_down = (const float*)d_in[15]; p.n_post_ffn = (const float*)d_in[16];
    p.out = (float*)d_out; p.ws = (unsigned char*)d_ws;
    if (hipMemsetAsync((char*)d_ws + WS_BAR, 0, 3456 * 4, stream) != hipSuccess) { fprintf(stderr, "kernel_launch: barrier memset failed\n"); return; }
#if MK_FUSED
    p.ph_lo = 0; p.ph_hi = 10;
    { void* args[] = {&p}; hipError_t e = hipLaunchCooperativeKernel((const void*)hymba_fwd, dim3(grid), dim3(512), args, LDS_BYTES, stream);
      if (e != hipSuccess) fprintf(stderr, "cooperative launch failed: %s (grid %d)\n", hipGetErrorString(e), grid); }
#else
    for (int ph = 0; ph < MK_NPH; ++ph) { p.ph_lo = ph; p.ph_hi = ph + 1; void* args[] = {&p};
      hipError_t e = hipLaunchCooperativeKernel((const void*)hymba_fwd, dim3(grid), dim3(512), args, LDS_BYTES, stream);
      if (e != hipSuccess) fprintf(stderr, "launch %d failed: %s (grid %d)\n", ph, hipGetErrorString(e), grid); }
#endif
}
```
